# Optimizing an MI355X kernel written in HIP

```python
import jax
import jax.numpy as jnp
from jax import lax
import numpy as np

D_MODEL = 1024
BATCH = 8
SEQ = 2048
DEPTH = 4

CONV_K = 4
NORM_EPS = 1e-6
RG_WIDTH = 512
RG_BLOCKS = 8
RG_BLOCK = RG_WIDTH // RG_BLOCKS
RG_C = 8.0
ML_HEADS = 4
ML_DH = 128
ML_WIDTH = ML_HEADS * ML_DH
ML_CHUNK = 64
GD_HEADS = 4
GD_DK = 128
GD_DV = 128
GD_QK = GD_HEADS * GD_DK
GD_WIDTH = GD_HEADS * GD_DV
GD_CHUNK = 64
D_MIX = RG_WIDTH + ML_WIDTH + GD_WIDTH
IN_SIZES = (RG_WIDTH, RG_WIDTH,
            ML_WIDTH, ML_WIDTH, ML_WIDTH, ML_WIDTH, ML_WIDTH, ML_HEADS, ML_HEADS,
            GD_QK, GD_QK, GD_WIDTH, GD_WIDTH, GD_HEADS, GD_HEADS)
D_IN = sum(IN_SIZES)

kernel_name = "hymba_rglru_mlstm_gdn_trunk"


def rmsnorm(x, w):
    xf = x.astype(jnp.float32)
    r = lax.rsqrt(jnp.mean(xf * xf, axis=-1, keepdims=True) + NORM_EPS)
    return (xf * r).astype(x.dtype) * w


def _rms_f32(x):
    return x * lax.rsqrt(jnp.mean(x * x, axis=-1, keepdims=True) + NORM_EPS)


def _l2norm(x):
    return x * lax.rsqrt(jnp.sum(x * x, axis=-1, keepdims=True) + NORM_EPS)


def causal_dwconv(x, w):
    K = w.shape[0]
    S = x.shape[1]
    xp = jnp.pad(x, ((0, 0), (K - 1, 0), (0, 0)))
    y = xp[:, 0:S] * w[0]
    for k in range(1, K):
        y = y + xp[:, k:k + S] * w[k]
    return y


def _lin_combine(left, right):
    a_l, b_l = left
    a_r, b_r = right
    return a_l * a_r, a_r * b_l + b_r


def rglru_branch(xb, zb, conv_w, conv_b, gate_w, gate_b, lam):
    Bn, S, _ = xb.shape
    xc = causal_dwconv(xb, conv_w) + conv_b
    xblk = xc.reshape(Bn, S, RG_BLOCKS, RG_BLOCK)
    gates = jnp.einsum('bsnc,gncd->gbsnd', xblk, gate_w).reshape(2, Bn, S, RG_WIDTH)
    gates = gates + gate_b[:, None, None, :]
    r = jax.nn.sigmoid(gates[0])
    i = jax.nn.sigmoid(gates[1])
    log_a = -RG_C * r * jax.nn.softplus(-lam)
    a = jnp.exp(log_a)
    b = jnp.sqrt(-jnp.expm1(2.0 * log_a)) * (i * xc)
    _, h = lax.associative_scan(_lin_combine, (a, b), axis=1)
    return h * jax.nn.silu(zb)


def mlstm_branch(q, k, v, o_pre, z, i_pre, f_pre, gate_b, norm_w):
    Bn, S, _ = q.shape
    L = ML_CHUNK
    N = S // L

    def chunks(t):
        return t.reshape(Bn, N, L, ML_HEADS, ML_DH).transpose(1, 0, 3, 2, 4)

    def chunks_s(t):
        return t.reshape(Bn, N, L, ML_HEADS).transpose(1, 0, 3, 2)

    qc = chunks(q) * (ML_DH ** -0.5)
    kc = chunks(k)
    vc = chunks(v)
    li = chunks_s(i_pre + gate_b[0])
    lf = chunks_s(jax.nn.log_sigmoid(f_pre + gate_b[1]))
    bcum = jnp.cumsum(lf, axis=-1)
    causal = jnp.tril(jnp.ones((L, L), dtype=bool))
    dmat = jnp.where(causal, bcum[..., :, None] - bcum[..., None, :] + li[..., None, :], -jnp.inf)
    w_state = bcum[..., -1:] - bcum + li

    def step(carry, xs):
        C, n, m = carry
        dm, bq, ws, qi, ki, vi = xs
        m_inter = bq + m[..., None]
        m_t = jnp.maximum(m_inter, jnp.max(dm, axis=-1))
        p = jnp.exp(dm - m_t[..., None])
        s = jnp.einsum('bhtd,bhsd->bhts', qi, ki) * p
        sc = jnp.exp(m_inter - m_t)
        num = jnp.einsum('bhts,bhse->bhte', s, vi) + sc[..., None] * jnp.einsum('bhtd,bhde->bhte', qi, C)
        den = jnp.sum(s, axis=-1) + sc * jnp.einsum('bhtd,bhd->bht', qi, n)
        h = num / jnp.maximum(jnp.abs(den), jnp.exp(-m_t))[..., None]
        g = bq[..., -1]
        m_new = jnp.maximum(g + m, jnp.max(ws, axis=-1))
        dec = jnp.exp(g + m - m_new)
        wk = jnp.exp(ws - m_new[..., None])
        C = dec[..., None, None] * C + jnp.einsum('bhs,bhsd,bhse->bhde', wk, ki, vi)
        n = dec[..., None] * n + jnp.einsum('bhs,bhsd->bhd', wk, ki)
        return (C, n, m_new), h

    init = (jnp.zeros((Bn, ML_HEADS, ML_DH, ML_DH), jnp.float32),
            jnp.zeros((Bn, ML_HEADS, ML_DH), jnp.float32),
            jnp.zeros((Bn, ML_HEADS), jnp.float32))
    _, h = lax.scan(step, init, (dmat, bcum, w_state, qc, kc, vc))
    h = h.transpose(1, 0, 3, 2, 4).reshape(Bn, S, ML_HEADS, ML_DH)
    h = _rms_f32(h) * norm_w.reshape(ML_HEADS, ML_DH)
    h = h.reshape(Bn, S, ML_WIDTH)
    return h * jax.nn.sigmoid(o_pre) * jax.nn.silu(z)


def gdn_branch(q, k, v, z, a_pre, b_pre, conv_w, a_log, dt_bias, norm_w):
    Bn, S, _ = q.shape
    L = GD_CHUNK
    N = S // L
    qkv = jax.nn.silu(causal_dwconv(jnp.concatenate([q, k, v], axis=-1), conv_w))
    q, k, v = jnp.split(qkv, [GD_QK, 2 * GD_QK], axis=-1)

    def chunks(t, d):
        return t.reshape(Bn, N, L, GD_HEADS, d).transpose(0, 3, 1, 2, 4)

    def chunks_s(t):
        return t.reshape(Bn, N, L, GD_HEADS).transpose(0, 3, 1, 2)

    q = _l2norm(chunks(q, GD_DK)) * (GD_DK ** -0.5)
    k = _l2norm(chunks(k, GD_DK))
    v = chunks(v, GD_DV)
    beta = chunks_s(jax.nn.sigmoid(b_pre))
    g = chunks_s(-jnp.exp(a_log) * jax.nn.softplus(a_pre + dt_bias))
    gc = jnp.cumsum(g, axis=-1)
    incl = jnp.tril(jnp.ones((L, L), dtype=bool))
    strict = jnp.tril(jnp.ones((L, L), dtype=bool), k=-1)
    gam = jnp.exp(jnp.where(incl, gc[..., :, None] - gc[..., None, :], -jnp.inf))
    kb = k * beta[..., None]
    m_strict = jnp.where(strict, jnp.einsum('bhntd,bhnsd->bhnts', kb, k) * gam, 0.0)
    eye = jnp.eye(L, dtype=m_strict.dtype)
    t_inv = lax.linalg.triangular_solve(eye + m_strict, jnp.broadcast_to(eye, m_strict.shape),
                                        left_side=True, lower=True, unit_diagonal=True)
    u = t_inv @ (v * beta[..., None])
    w = t_inv @ (kb * jnp.exp(gc)[..., None])
    aqk = jnp.einsum('bhntd,bhnsd->bhnts', q, k) * gam
    q_dec = q * jnp.exp(gc)[..., None]
    g_last = gc[..., -1]
    k_dec = k * jnp.exp(g_last[..., None] - gc)[..., None]
    xs = (jnp.moveaxis(u, 2, 0), jnp.moveaxis(w, 2, 0), jnp.moveaxis(aqk, 2, 0),
          jnp.moveaxis(q_dec, 2, 0), jnp.moveaxis(k_dec, 2, 0), jnp.moveaxis(g_last, 2, 0))

    def step(state, xs_i):
        ui, wi, ai, qi, ki, gl = xs_i
        v_new = ui - wi @ state
        o = qi @ state + ai @ v_new
        state = state * jnp.exp(gl)[..., None, None] + jnp.swapaxes(ki, -1, -2) @ v_new
        return state, o

    _, o = lax.scan(step, jnp.zeros((Bn, GD_HEADS, GD_DK, GD_DV), jnp.float32), xs)
    o = o.transpose(1, 0, 3, 2, 4).reshape(Bn, S, GD_HEADS, GD_DV)
    o = _rms_f32(o) * norm_w * jax.nn.silu(z.reshape(Bn, S, GD_HEADS, GD_DV))
    return o.reshape(Bn, S, GD_WIDTH)


def setup_inputs(seed: int = 0) -> dict:
    key = jax.random.key(seed)
    ks = jax.random.split(key, 17)
    f32 = jnp.float32
    nrm = jax.random.normal
    x = nrm(ks[0], (BATCH, SEQ, D_MODEL), f32)
    norm_w = 1.0 + 0.02 * nrm(ks[1], (DEPTH, D_MODEL), f32)
    w_in = nrm(ks[2], (DEPTH, D_MODEL, D_IN), f32) * (D_MODEL ** -0.5)
    rg_conv_w = nrm(ks[3], (DEPTH, CONV_K, RG_WIDTH), f32) * (CONV_K ** -0.5)
    rg_conv_b = 0.01 * nrm(ks[4], (DEPTH, RG_WIDTH), f32)
    rg_gate_w = nrm(ks[5], (DEPTH, 2, RG_BLOCKS, RG_BLOCK, RG_BLOCK), f32) * (RG_BLOCK ** -0.5)
    rg_gate_b = 0.01 * nrm(ks[6], (DEPTH, 2, RG_WIDTH), f32)
    a_c = jax.random.uniform(ks[7], (DEPTH, RG_WIDTH), f32, minval=0.9, maxval=0.999)
    a0 = a_c ** (1.0 / RG_C)
    rg_lambda = jnp.log(a0) - jnp.log1p(-a0)
    ml_i_b = 0.1 * nrm(ks[8], (DEPTH, ML_HEADS), f32)
    ml_f_b = jnp.linspace(3.0, 6.0, ML_HEADS, dtype=f32)[None, :] + 0.1 * nrm(ks[9], (DEPTH, ML_HEADS), f32)
    ml_gate_b = jnp.stack([ml_i_b, ml_f_b], axis=1)
    ml_norm_w = 1.0 + 0.02 * nrm(ks[10], (DEPTH, ML_WIDTH), f32)
    gd_conv_w = nrm(ks[11], (DEPTH, CONV_K, 2 * GD_QK + GD_WIDTH), f32) * (CONV_K ** -0.5)
    gd_a_log = jnp.log(jax.random.uniform(ks[12], (DEPTH, GD_HEADS), f32, minval=1.0, maxval=16.0))
    dt = jnp.exp(jax.random.uniform(ks[13], (DEPTH, GD_HEADS), f32,
                                    minval=float(np.log(1e-3)), maxval=float(np.log(1e-1))))
    gd_dt_bias = dt + jnp.log(-jnp.expm1(-dt))
    gd_norm_w = 1.0 + 0.02 * nrm(ks[14], (DEPTH, GD_DV), f32)
    w_out = nrm(ks[15], (DEPTH, D_MIX, D_MODEL), f32) * (D_MIX ** -0.5)
    final_norm_w = 1.0 + 0.02 * nrm(ks[16], (D_MODEL,), f32)
    return {"x": x, "norm_w": norm_w, "w_in": w_in, "rg_conv_w": rg_conv_w, "rg_conv_b": rg_conv_b,
            "rg_gate_w": rg_gate_w, "rg_gate_b": rg_gate_b, "rg_lambda": rg_lambda,
            "ml_gate_b": ml_gate_b, "ml_norm_w": ml_norm_w, "gd_conv_w": gd_conv_w,
            "gd_a_log": gd_a_log, "gd_dt_bias": gd_dt_bias, "gd_norm_w": gd_norm_w,
            "w_out": w_out, "final_norm_w": final_norm_w}


def reference(x, norm_w, w_in, rg_conv_w, rg_conv_b, rg_gate_w, rg_gate_b, rg_lambda,
              ml_gate_b, ml_norm_w, gd_conv_w, gd_a_log, gd_dt_bias, gd_norm_w,
              w_out, final_norm_w):
    split_idx = [int(c) for c in np.cumsum(IN_SIZES)[:-1]]
    for l in range(DEPTH):
        hn = rmsnorm(x, norm_w[l])
        proj = (hn @ w_in[l]).astype(jnp.float32)
        (rg_x, rg_z, ml_q, ml_k, ml_v, ml_o, ml_z, ml_i, ml_f,
         gd_q, gd_k, gd_v, gd_z, gd_a, gd_b) = jnp.split(proj, split_idx, axis=-1)
        y_rg = rglru_branch(rg_x, rg_z, rg_conv_w[l], rg_conv_b[l], rg_gate_w[l], rg_gate_b[l], rg_lambda[l])
        y_ml = mlstm_branch(ml_q, ml_k, ml_v, ml_o, ml_z, ml_i, ml_f, ml_gate_b[l], ml_norm_w[l])
        y_gd = gdn_branch(gd_q, gd_k, gd_v, gd_z, gd_a, gd_b, gd_conv_w[l], gd_a_log[l],
                          gd_dt_bias[l], gd_norm_w[l])
        y = jnp.concatenate([y_rg, y_ml, y_gd], axis=-1)
        x = x + y.astype(x.dtype) @ w_out[l]
    return rmsnorm(x, final_norm_w)
```

```cpp
#include <hip/hip_runtime.h>
#include <hip/hip_cooperative_groups.h>
#include <cstdio>
namespace cg = cooperative_groups;

#define LAS __attribute__((address_space(3)))
typedef unsigned short bf16_t;
typedef short bf16x8 __attribute__((ext_vector_type(8)));
typedef float f32x4 __attribute__((ext_vector_type(4)));
typedef unsigned u32x4 __attribute__((ext_vector_type(4)));
typedef unsigned u32x2 __attribute__((ext_vector_type(2)));

constexpr int NTOK = 16384, DM = 1024, DIN = 5648, NPROJ = 5632, NPAD = 5888, DMIX = 1536, DEPTH = 4, SEQ = 2048;
constexpr int YOFF = 3584;
constexpr int COL_RGX = 0, COL_RGZ = 512, COL_MLQ = 1024, COL_MLK = 1536, COL_MLV = 2048, COL_MLO = 2560, COL_MLZ = 3072, COL_GDQ = 3584, COL_GDZ = 5120;
constexpr float QSCALE = 0.08838834764831845f;
constexpr float EPS = 1e-6f;
constexpr int LDS_BYTES = 159744;

constexpr size_t WS_BTIN = 0;
constexpr size_t WS_BTOUT = WS_BTIN + (size_t)NPAD * DM * 2;
constexpr size_t WS_WT16 = WS_BTOUT + (size_t)DEPTH * DM * DMIX * 2;
constexpr size_t WS_XB = WS_WT16 + (size_t)DEPTH * 2 * 8 * 64 * 64 * 2;
constexpr size_t WS_SSQ = WS_XB + (size_t)NTOK * DM * 2;
constexpr size_t WS_GATES = WS_SSQ + (size_t)NTOK * 16 * 4;
constexpr size_t WS_RGSUM = WS_GATES + (size_t)NTOK * 16 * 4;
constexpr size_t WS_PROJ = WS_RGSUM + (size_t)8 * 32 * 512 * 2 * 4;
constexpr size_t WS_MLREC = WS_PROJ + (size_t)NTOK * NPROJ * 2;
constexpr int MLREC_BYTES = 16384 + 16384 + 2048;
constexpr size_t WS_GDREC = WS_MLREC + (size_t)1024 * MLREC_BYTES;
constexpr int GDREC_BYTES = 73984;
constexpr size_t WS_BAR = WS_GDREC + (size_t)1024 * GDREC_BYTES;
constexpr size_t WS_BAR_BYTES = 16384;
constexpr size_t WS_END = WS_BAR + WS_BAR_BYTES;

struct Params {
    const float* x; const float* norm_w; const float* w_in; const float* rg_conv_w; const float* rg_conv_b; const float* rg_gate_w; const float* rg_gate_b;
    const float* rg_lambda; const float* ml_gate_b; const float* ml_norm_w; const float* gd_conv_w; const float* gd_a_log; const float* gd_dt_bias;
    const float* gd_norm_w; const float* w_out; const float* final_norm_w;
    float* out; unsigned char* ws;
};

__device__ __forceinline__ int opaque_s(int v) { asm volatile("" : "+s"(v)); return v; }
__device__ __forceinline__ int opaque_tid() { int t = threadIdx.x; asm volatile("" : "+v"(t)); return t; }
typedef __bf16 hbf16x2 __attribute__((ext_vector_type(2)));
typedef float f32x2v __attribute__((ext_vector_type(2)));
__device__ __forceinline__ bf16_t f2bf(float f) { const __bf16 h = (__bf16)f; return __builtin_bit_cast(bf16_t, h); }
__device__ __forceinline__ float bf2f(bf16_t b) { return __uint_as_float(((unsigned)b) << 16); }
__device__ __forceinline__ unsigned pack2(float lo, float hi) { const f32x2v v = {lo, hi}; return __builtin_bit_cast(unsigned, __builtin_convertvector(v, hbf16x2)); }
__device__ __forceinline__ float bflo(unsigned w) { return __uint_as_float(w << 16); }
__device__ __forceinline__ float bfhi(unsigned w) { return __uint_as_float(w & 0xFFFF0000u); }
__device__ __forceinline__ float sigmoid_(float x) { return __builtin_amdgcn_rcpf(1.f + __expf(-x)); }
__device__ __forceinline__ float silu_(float x) { return x * __builtin_amdgcn_rcpf(1.f + __expf(-x)); }
__device__ __forceinline__ float neg_expm1_(float x) { const float ps = -x * (1.f + x * (0.5f + x * (0.16666667f + x * (0.041666668f + x * (0.0083333338f + x * 0.0013888889f))))); return x > -0.25f ? ps : 1.f - __expf(x); }
__device__ __forceinline__ float softplus_(float x) { return fmaxf(x, 0.f) + log1pf(__expf(-fabsf(x))); }
__device__ __forceinline__ float sum8_dpp(float v) {
    v += __builtin_bit_cast(float, __builtin_amdgcn_mov_dpp(__builtin_bit_cast(int, v), 0xB1, 0xF, 0xF, true));
    v += __builtin_bit_cast(float, __builtin_amdgcn_mov_dpp(__builtin_bit_cast(int, v), 0x4E, 0xF, 0xF, true));
    v += __builtin_bit_cast(float, __builtin_amdgcn_mov_dpp(__builtin_bit_cast(int, v), 0x141, 0xF, 0xF, true));
    return v;
}
__device__ __forceinline__ float sum16_dpp(float v) {
    v = sum8_dpp(v);
    v += __builtin_bit_cast(float, __builtin_amdgcn_mov_dpp(__builtin_bit_cast(int, v), 0x140, 0xF, 0xF, true));
    return v;
}
__device__ __forceinline__ float sum4_dpp(float v) {
    v += __builtin_bit_cast(float, __builtin_amdgcn_mov_dpp(__builtin_bit_cast(int, v), 0xB1, 0xF, 0xF, true));
    v += __builtin_bit_cast(float, __builtin_amdgcn_mov_dpp(__builtin_bit_cast(int, v), 0x4E, 0xF, 0xF, true));
    return v;
}
__device__ __forceinline__ float wave_sum(float v) { for (int o = 32; o; o >>= 1) v += __shfl_xor(v, o); return v; }
#define DPP_F(old, v, ctrl, rm, bc) __builtin_bit_cast(float, __builtin_amdgcn_update_dpp(__builtin_bit_cast(int, (float)(old)), __builtin_bit_cast(int, (float)(v)), ctrl, rm, 0xF, bc))
__device__ __forceinline__ float wave_incl_sum(float v, int) {
    v += DPP_F(0.f, v, 0x111, 0xF, true); v += DPP_F(0.f, v, 0x112, 0xF, true); v += DPP_F(0.f, v, 0x114, 0xF, true); v += DPP_F(0.f, v, 0x118, 0xF, true);
    v += DPP_F(0.f, v, 0x142, 0xA, false); v += DPP_F(0.f, v, 0x143, 0xC, false);
    return v;
}
__device__ __forceinline__ float wave_incl_max(float v, int) {
    const float ninf = -__builtin_inff();
    v = fmaxf(v, DPP_F(ninf, v, 0x111, 0xF, false)); v = fmaxf(v, DPP_F(ninf, v, 0x112, 0xF, false)); v = fmaxf(v, DPP_F(ninf, v, 0x114, 0xF, false)); v = fmaxf(v, DPP_F(ninf, v, 0x118, 0xF, false));
    v = fmaxf(v, DPP_F(ninf, v, 0x142, 0xA, false)); v = fmaxf(v, DPP_F(ninf, v, 0x143, 0xC, false));
    return v;
}
__device__ __forceinline__ float wave_max(float v) { return __builtin_bit_cast(float, __builtin_amdgcn_readlane(__builtin_bit_cast(int, wave_incl_max(v, 0)), 63)); }
__device__ __forceinline__ f32x4 mfma16(bf16x8 a, bf16x8 b, f32x4 c) { return __builtin_amdgcn_mfma_f32_16x16x32_bf16(a, b, c, 0, 0, 0); }
__device__ __forceinline__ bf16x8 pack_b(const f32x4& t0, const f32x4& t1) {
    u32x4 w; w.x = pack2(t0[0], t0[1]); w.y = pack2(t0[2], t0[3]); w.z = pack2(t1[0], t1[1]); w.w = pack2(t1[2], t1[3]);
    return __builtin_bit_cast(bf16x8, w);
}
__device__ __forceinline__ int permpos(int nat) { return ((nat >> 2) & 3) * 8 + (nat >> 4) * 4 + (nat & 3); }

namespace pg8 {
constexpr int BM = 256, BK = 64, HALF = 128, HTB = HALF * BK * 2, NXCD = 8, WGM = 8;
__device__ __forceinline__ int lds_byte(int r, int c) { const int st = (r >> 4) * 2 + (c >> 5), rr = r & 15, cc = c & 31, ob = rr * 64 + cc * 2; return st * 1024 + (ob ^ (((ob >> 9) & 1) << 5)); }
__device__ __forceinline__ void stage_rc(int b, int& R, int& C) { const int st = b / 1024, sb = b % 1024, swz = sb ^ (((sb >> 9) & 1) << 5); R = (st >> 1) * 16 + swz / 64; C = (st & 1) * 32 + (swz % 64) / 2; }
__device__ __forceinline__ int perm32(int rho) { const int n = rho >> 4, i = rho & 15; return 8 * (i >> 2) + 4 * n + (i & 3); }
struct Unit { int pm, pn; };
struct Gemm { const bf16_t* A; const bf16_t* Bt; int M, N, K, lda; };
struct StaticOrder {
    int nM, nN, nwg, G, c;
    __device__ __forceinline__ void init(int M, int N, int G_, int c_) { nM = M / BM; nN = N / BM; nwg = nM * nN; G = G_; c = c_; }
    __device__ __forceinline__ bool next(int i, Unit& u) const {
        const long L = (long)i * G + c; if (L >= nwg) return false;
        int wgid = (int)L; { const int q = nwg / NXCD, r = nwg % NXCD, xcd = wgid % NXCD, off = wgid / NXCD; wgid = (xcd < r ? xcd * (q + 1) : r * (q + 1) + (xcd - r) * q) + off; }
        const int nig = WGM * nN, gid = wgid / nig, fm = gid * WGM, gsz = (nM - fm) < WGM ? (nM - fm) : WGM;
        u.pm = __builtin_amdgcn_readfirstlane(fm + ((wgid % nig) % gsz)); u.pn = __builtin_amdgcn_readfirstlane((wgid % nig) / gsz); return true;
    }
};
template <class Epi>
__device__ __forceinline__ void gemm_phase(LAS unsigned char* lds, const Gemm g, const StaticOrder& S, const Epi& E) {
    const int tid = opaque_tid(), wid = __builtin_amdgcn_readfirstlane(tid >> 6), lane = tid & 63, wr = wid >> 2, wc = wid & 3, fr = lane & 15, fq = lane >> 4;
    const int K = g.K, nt = K / BK, lda = g.lda;
    unsigned voffA[2], voffB[2];
#pragma unroll
    for (int i = 0; i < 2; ++i) { int R, C; stage_rc(tid * 16 + i * 8192, R, C); const int Rb = (R & ~31) + perm32(R & 31);
        voffA[i] = (unsigned)(R * lda + C) * 2u; voffB[i] = (unsigned)(Rb * K + C) * 2u; }
    const size_t kstep = (size_t)(BK * 2);
    const size_t hstepA = (size_t)HALF * lda * 2, hstepB = (size_t)HALF * K * 2;
    const size_t tstepA = 2 * hstepA, tstepB = 2 * hstepB;
    const unsigned ldsw = (unsigned)wid * 1024u;
    const int aoff = lds_byte(wr * 64 + fr, fq * 8), boff = lds_byte(wc * 32 + fr, fq * 8);
#define PG8_SA(b, h) (((b) * 2 + (h)) * HTB)
#define PG8_SB(b, h) ((4 + (b) * 2 + (h)) * HTB)
#define PG8_STAGE(bufoff, gbase, voff) do { _Pragma("unroll") for (int _i = 0; _i < 2; ++_i) \
        __builtin_amdgcn_global_load_lds((const unsigned*)((const char*)(gbase) + (voff)[_i]), (LAS unsigned*)(lds + (bufoff) + ldsw + _i * 8192), 16, 0, 0); } while (0)
#define PG8_LDA(dst, b, h) do { _Pragma("unroll") for (int m = 0; m < 4; ++m) _Pragma("unroll") for (int k = 0; k < 2; ++k) dst[m][k] = *(const LAS bf16x8*)(lds + PG8_SA(b, h) + aoff + m * 2048 + k * 1024); } while (0)
#define PG8_LDB(dst, b, h) do { _Pragma("unroll") for (int n = 0; n < 2; ++n) _Pragma("unroll") for (int k = 0; k < 2; ++k) dst[n][k] = *(const LAS bf16x8*)(lds + PG8_SB(b, h) + boff + n * 2048 + k * 1024); } while (0)
#define PG8_MMA(ai, bj, At, Bt) do { __builtin_amdgcn_s_setprio(1); _Pragma("unroll") for (int m = 0; m < 4; ++m) _Pragma("unroll") for (int n = 0; n < 2; ++n) _Pragma("unroll") for (int k = 0; k < 2; ++k) \
        acc[ai][bj][m][n] = __builtin_amdgcn_mfma_f32_16x16x32_bf16(Bt[n][k], At[m][k], acc[ai][bj][m][n], 0, 0, 0); __builtin_amdgcn_s_setprio(0); } while (0)
#define PG8_WAIT_V(n) asm volatile("s_waitcnt vmcnt(" #n ")" ::: "memory")
#define PG8_WAIT_L(n) asm volatile("s_waitcnt lgkmcnt(" #n ")" ::: "memory")
#define PG8_BAR __builtin_amdgcn_s_barrier()
#define PG8_SCHED __builtin_amdgcn_sched_barrier(0)
    Unit cur, nxt; int ui = 0;
    if (!S.next(0, cur)) return;
    f32x4 acc[2][2][4][2];
#pragma unroll
    for (int a = 0; a < 2; ++a)
#pragma unroll
        for (int b = 0; b < 2; ++b)
#pragma unroll
            for (int m = 0; m < 4; ++m)
#pragma unroll
                for (int n = 0; n < 2; ++n) acc[a][b][m][n] = (f32x4){0.f, 0.f, 0.f, 0.f};
    bf16x8 At[4][2], B0[2][2], B1[2][2];
    const char* cA = (const char*)g.A + (size_t)cur.pm * tstepA; const char* cB = (const char*)g.Bt + (size_t)cur.pn * tstepB;
    PG8_STAGE(PG8_SB(0, 0), cB, voffB); PG8_STAGE(PG8_SA(0, 0), cA, voffA); PG8_STAGE(PG8_SB(0, 1), cB + hstepB, voffB); PG8_STAGE(PG8_SA(0, 1), cA + hstepA, voffA);
    if (wr == 1) PG8_BAR;
    PG8_WAIT_V(4); PG8_BAR;
    PG8_STAGE(PG8_SB(1, 0), cB + kstep, voffB); PG8_STAGE(PG8_SA(1, 0), cA + kstep, voffA); PG8_STAGE(PG8_SB(1, 1), cB + hstepB + kstep, voffB);
    PG8_WAIT_V(6); PG8_BAR;
    for (;;) {
        const bool has_next = S.next(ui + 1, nxt);
        const char* nA = has_next ? (const char*)g.A + (size_t)nxt.pm * tstepA : cA; const char* nB = has_next ? (const char*)g.Bt + (size_t)nxt.pn * tstepB : cB;
        for (int t = 0; t < nt; t += 2) {
            const bool last = (t == nt - 2);
            const char* a1 = cA + (size_t)(t + 1) * kstep;
            const char* a2 = last ? nA : cA + (size_t)(t + 2) * kstep; const char* b2 = last ? nB : cB + (size_t)(t + 2) * kstep;
            const char* a3 = a2 + kstep; const char* b3 = b2 + kstep;
            PG8_LDB(B0, 0, 0); PG8_SCHED; PG8_LDA(At, 0, 0); PG8_STAGE(PG8_SA(1, 1), a1 + hstepA, voffA);
            PG8_WAIT_L(8); PG8_BAR; PG8_WAIT_L(0); PG8_MMA(0, 0, At, B0); PG8_BAR; PG8_SCHED;
            PG8_LDB(B1, 0, 1); PG8_STAGE(PG8_SB(0, 0), b2, voffB);
            PG8_BAR; PG8_WAIT_L(0); PG8_MMA(0, 1, At, B1); PG8_BAR;
            PG8_LDA(At, 0, 1); PG8_STAGE(PG8_SA(0, 0), a2, voffA);
            PG8_BAR; PG8_WAIT_L(0); PG8_MMA(1, 0, At, B0); PG8_BAR; PG8_SCHED;
            PG8_STAGE(PG8_SB(0, 1), b2 + hstepB, voffB);
            PG8_WAIT_V(6); PG8_BAR; PG8_MMA(1, 1, At, B1); PG8_BAR;
            PG8_LDB(B0, 1, 0); PG8_SCHED; PG8_LDA(At, 1, 0); PG8_STAGE(PG8_SA(0, 1), a2 + hstepA, voffA);
            PG8_WAIT_L(8); PG8_BAR; PG8_WAIT_L(0); PG8_MMA(0, 0, At, B0); PG8_BAR; PG8_SCHED;
            PG8_LDB(B1, 1, 1); PG8_STAGE(PG8_SB(1, 0), b3, voffB);
            PG8_BAR; PG8_WAIT_L(0); PG8_MMA(0, 1, At, B1); PG8_BAR;
            PG8_LDA(At, 1, 1); PG8_STAGE(PG8_SA(1, 0), a3, voffA);
            PG8_BAR; PG8_WAIT_L(0); PG8_MMA(1, 0, At, B0); PG8_BAR; PG8_SCHED;
            PG8_STAGE(PG8_SB(1, 1), b3 + hstepB, voffB);
            PG8_WAIT_V(6); PG8_BAR; PG8_MMA(1, 1, At, B1); PG8_BAR;
        }
        E(acc, cur, wr, wc, fr, fq, ui);
        if (!has_next) break;
#pragma unroll
        for (int a = 0; a < 2; ++a)
#pragma unroll
            for (int b = 0; b < 2; ++b)
#pragma unroll
                for (int m = 0; m < 4; ++m)
#pragma unroll
                    for (int n = 0; n < 2; ++n) acc[a][b][m][n] = (f32x4){0.f, 0.f, 0.f, 0.f};
        cur = nxt; cA = nA; cB = nB; ++ui;
    }
    PG8_WAIT_V(0);
    if (wr == 0) PG8_BAR;
    PG8_BAR;
#undef PG8_SA
#undef PG8_SB
#undef PG8_STAGE
#undef PG8_LDA
#undef PG8_LDB
#undef PG8_MMA
#undef PG8_WAIT_V
#undef PG8_WAIT_L
#undef PG8_BAR
#undef PG8_SCHED
}
}

struct EpiIn {
    bf16_t* proj; float* gates; const LAS float* rtab; int ui;
    __device__ __forceinline__ void operator()(const f32x4 (&acc)[2][2][4][2], const pg8::Unit& u, int wr, int wc, int fr, int fq, int uidx) const {
        const int row0 = u.pm * 256 + wr * 64 + fr;
        const LAS float* rt = rtab + uidx * 256 + wr * 64 + fr;
#pragma unroll
        for (int ai = 0; ai < 2; ++ai)
#pragma unroll
            for (int m = 0; m < 4; ++m) {
                const int row = row0 + ai * 128 + m * 16;
                const float r = rt[ai * 128 + m * 16];
                if (u.pn < 22) {
#pragma unroll
                    for (int bj = 0; bj < 2; ++bj) {
                        const int col = u.pn * 256 + bj * 128 + wc * 32 + 8 * fq;
                        const f32x4 v0 = acc[ai][bj][m][0] * r, v1 = acc[ai][bj][m][1] * r;
                        u32x4 w; w.x = pack2(v0[0], v0[1]); w.y = pack2(v0[2], v0[3]); w.z = pack2(v1[0], v1[1]); w.w = pack2(v1[2], v1[3]);
                        *(u32x4*)(proj + (size_t)row * NPROJ + col) = w;
                    }
                } else if (wc == 0 && fq < 2) {
                    float* gp = gates + (size_t)row * 16 + 8 * fq;
                    *(f32x4*)gp = acc[ai][0][m][0] * r; *(f32x4*)(gp + 4) = acc[ai][0][m][1] * r;
                }
                __builtin_amdgcn_sched_barrier(0);
            }
    }
};
struct EpiOut {
    float* xout; bf16_t* xb; float* ssq; int last;
    __device__ __forceinline__ void operator()(const f32x4 (&acc)[2][2][4][2], const pg8::Unit& u, int wr, int wc, int fr, int fq, int uidx) const {
        const int row0 = u.pm * 256 + wr * 64 + fr;
#pragma unroll
        for (int ai = 0; ai < 2; ++ai)
#pragma unroll
            for (int m = 0; m < 4; ++m) {
                const int row = row0 + ai * 128 + m * 16; float ss = 0.f;
#pragma unroll
                for (int bj = 0; bj < 2; ++bj) {
                    const int col = u.pn * 256 + bj * 128 + wc * 32 + 8 * fq;
                    const size_t o = (size_t)row * DM + col;
                    const u32x4 xo = *(const u32x4*)(xb + o);
                    f32x4 v0, v1;
                    v0[0] = bflo(xo.x) + acc[ai][bj][m][0][0]; v0[1] = bfhi(xo.x) + acc[ai][bj][m][0][1]; v0[2] = bflo(xo.y) + acc[ai][bj][m][0][2]; v0[3] = bfhi(xo.y) + acc[ai][bj][m][0][3];
                    v1[0] = bflo(xo.z) + acc[ai][bj][m][1][0]; v1[1] = bfhi(xo.z) + acc[ai][bj][m][1][1]; v1[2] = bflo(xo.w) + acc[ai][bj][m][1][2]; v1[3] = bfhi(xo.w) + acc[ai][bj][m][1][3];
                    if (last) { *(f32x4*)(xout + o) = v0; *(f32x4*)(xout + o + 4) = v1; }
                    u32x4 w; w.x = pack2(v0[0], v0[1]); w.y = pack2(v0[2], v0[3]); w.z = pack2(v1[0], v1[1]); w.w = pack2(v1[2], v1[3]);
                    *(u32x4*)(xb + o) = w;
                    ss += (v0[0] * v0[0] + v0[1] * v0[1]) + (v0[2] * v0[2] + v0[3] * v0[3]) + (v1[0] * v1[0] + v1[1] * v1[1]) + (v1[2] * v1[2] + v1[3] * v1[3]);
                }
                ss += __shfl_xor(ss, 16); ss += __shfl_xor(ss, 32);
                if (fq == 0) ssq[(size_t)row * 16 + u.pn * 4 + wc] = ss;
                __builtin_amdgcn_sched_barrier(0);
            }
    }
};

__device__ __forceinline__ int inproj_col(int n) { if (n < 3584) return n; if (n < 5632) return n + 8; const int g = n - 5632; if (g < 8) return 3584 + g; if (g < 16) return 5640 + (g - 8); return -1; }
__device__ __forceinline__ void cvt_tile_W(const float* __restrict__ src, int ld_src, int k0, int n0, bool inmap, const float* __restrict__ kscale, bf16_t* __restrict__ dst, int ld_dst) {
    const int lane = opaque_tid() & 63;
    const int col = inmap ? inproj_col(n0 + lane) : (n0 + lane);
    float v[64];
    const float* sp = src + (size_t)k0 * ld_src + (col >= 0 ? col : 0);
#pragma unroll
    for (int k = 0; k < 64; ++k) v[k] = sp[(size_t)k * ld_src];
    if (kscale) {
#pragma unroll
        for (int k = 0; k < 64; ++k) v[k] *= kscale[k0 + k];
    }
    if (col < 0) {
#pragma unroll
        for (int k = 0; k < 64; ++k) v[k] = 0.f;
    }
    bf16_t* dp = dst + (size_t)(n0 + lane) * ld_dst + k0;
#pragma unroll
    for (int i = 0; i < 8; ++i) { u32x4 w; w.x = pack2(v[i * 8], v[i * 8 + 1]); w.y = pack2(v[i * 8 + 2], v[i * 8 + 3]); w.z = pack2(v[i * 8 + 4], v[i * 8 + 5]); w.w = pack2(v[i * 8 + 6], v[i * 8 + 7]);
        *(u32x4*)(dp + i * 8) = w; }
}
constexpr int NU_BTIN = 92 * 16 / 8;
__device__ __forceinline__ void cvt_btin_unit(unsigned char* lds, const Params& p, int l, int u) {
    const int ti = u * 8 + (opaque_tid() >> 6), nt = ti >> 4, kt = ti & 15;
    cvt_tile_W(p.w_in + (size_t)l * DM * DIN, DIN, kt * 64, nt * 64, true, p.norm_w + l * DM, (bf16_t*)(p.ws + WS_BTIN), DM);
}
constexpr int NU_BTOUT = DEPTH * 24 * 16 / 8, NU_WT = 64 / 8, NU_XROWS = NTOK / 8;
constexpr int NU_P0 = NU_BTIN + NU_BTOUT + NU_WT + NU_XROWS;
__device__ __forceinline__ void p0_unit(unsigned char* lds, const Params& p, int u) {
    if (u < NU_BTIN) { cvt_btin_unit(lds, p, 0, u); return; }
    u -= NU_BTIN;
    if (u < NU_BTOUT) { const int ti = u * 8 + (opaque_tid() >> 6), l = ti / 384, r = ti % 384, kt = r >> 4, nt = r & 15;
        cvt_tile_W(p.w_out + (size_t)l * DMIX * DM, DM, kt * 64, nt * 64, false, nullptr, (bf16_t*)(p.ws + WS_BTOUT) + (size_t)l * DM * DMIX, DMIX); return; }
    u -= NU_BTOUT;
    if (u < NU_WT) { const int ti = u * 8 + (opaque_tid() >> 6); cvt_tile_W(p.rg_gate_w + (size_t)ti * 4096, 64, 0, 0, false, nullptr, (bf16_t*)(p.ws + WS_WT16) + (size_t)ti * 4096, 64); return; }
    u -= NU_WT;
    {
        const int tid = opaque_tid(), lane = tid & 63, wid = tid >> 6, row = u * 8 + wid;
        const float* xr = p.x + (size_t)row * DM; bf16_t* xb = (bf16_t*)(p.ws + WS_XB) + (size_t)row * DM; float ss = 0.f;
#pragma unroll
        for (int i = 0; i < 4; ++i) { const f32x4 v = *(const f32x4*)(xr + i * 256 + lane * 4); ss += (v[0] * v[0] + v[1] * v[1]) + (v[2] * v[2] + v[3] * v[3]);
            u32x2 w; w.x = pack2(v[0], v[1]); w.y = pack2(v[2], v[3]); *(u32x2*)(xb + i * 256 + lane * 4) = w; }
        ss = wave_sum(ss);
        if (lane < 16) ((float*)(p.ws + WS_SSQ))[(size_t)row * 16 + lane] = lane == 0 ? ss : 0.f;
    }
}

__device__ __forceinline__ void rg_unit(unsigned char* lds, const Params& p, int l, int b, int nb, int n, int mode) {
    const int tid = opaque_tid(), lane = tid & 63, wid = tid >> 6, r = lane & 15, q = lane >> 4;
    bf16_t* XC16 = (bf16_t*)lds; bf16_t* WT = (bf16_t*)(lds + 9216); float* XC = (float*)(lds + 27648); float* AA = (float*)(lds + 44288); float* BB = (float*)(lds + 60928);
    float* SEG = (float*)(lds + 77568); float* H0 = (float*)(lds + 81664);
    bf16_t* proj = (bf16_t*)(p.ws + WS_PROJ); float* rgsum = (float*)(p.ws + WS_RGSUM);
    const int t0 = n * 64, row0 = b * SEQ + t0, ch0 = nb * 64;
    float* SUM = (float*)(lds + 81920);
    f32x4 sm4[2] = {{0.f, 0.f, 0.f, 0.f}, {0.f, 0.f, 0.f, 0.f}};
    if (mode == 1) {
#pragma unroll
        for (int k = 0; k < 2; ++k) { const int i4 = tid + 512 * k, m = i4 >> 5, j4 = i4 & 31;
            if (m < n) sm4[k] = *(const f32x4*)(rgsum + ((size_t)(b * 32 + m) * 512 + ch0) * 2 + j4 * 4); }
    }
    {
        const int c = tid & 63, tg = tid >> 6, ch = ch0 + c;
        const float* cw = p.rg_conv_w + l * 4 * 512 + ch; const float w0 = cw[0], w1 = cw[512], w2 = cw[1024], w3 = cw[1536], cb = p.rg_conv_b[l * 512 + ch];
        float xv[11];
#pragma unroll
        for (int i = 0; i < 11; ++i) { const int ts = t0 + tg * 8 - 3 + i; xv[i] = ts >= 0 ? bf2f(proj[(size_t)(b * SEQ + ts) * NPROJ + COL_RGX + ch]) : 0.f; }
#pragma unroll
        for (int j = 0; j < 8; ++j) { const float v = w0 * xv[j] + w1 * xv[j + 1] + w2 * xv[j + 2] + w3 * xv[j + 3] + cb; const int t = tg * 8 + j; XC[t * 65 + c] = v; XC16[t * 72 + c] = f2bf(v); }
        const bf16_t* wsrc = (const bf16_t*)(p.ws + WS_WT16);
#pragma unroll
        for (int i = 0; i < 2; ++i) { const int ci = tid + 512 * i, rw = ci >> 3, sg = ci & 7, g = rw >> 6, d = rw & 63;
            *(u32x4*)(WT + rw * 72 + sg * 8) = *(const u32x4*)(wsrc + ((size_t)((l * 2 + g) * 8 + nb) * 64 + d) * 64 + sg * 8); }
    }
    __syncthreads();
    {
        const int tt = wid >> 1, dh = wid & 1;
        bf16x8 Af[2];
#pragma unroll
        for (int ks = 0; ks < 2; ++ks) Af[ks] = *(const bf16x8*)(XC16 + (tt * 16 + r) * 72 + ks * 32 + q * 8);
#pragma unroll
        for (int db = 0; db < 2; ++db) {
            const int dblk = dh * 2 + db;
            f32x4 ar = {0.f, 0.f, 0.f, 0.f}, ai = {0.f, 0.f, 0.f, 0.f};
#pragma unroll
            for (int ks = 0; ks < 2; ++ks) {
                ar = mfma16(Af[ks], *(const bf16x8*)(WT + (dblk * 16 + r) * 72 + ks * 32 + q * 8), ar);
                ai = mfma16(Af[ks], *(const bf16x8*)(WT + (64 + dblk * 16 + r) * 72 + ks * 32 + q * 8), ai);
            }
            const int d = dblk * 16 + r, ch = ch0 + d;
            const float br = p.rg_gate_b[l * 1024 + ch], bi = p.rg_gate_b[l * 1024 + 512 + ch], sp = softplus_(-p.rg_lambda[l * 512 + ch]);
#pragma unroll
            for (int j = 0; j < 4; ++j) {
                const int t = tt * 16 + q * 4 + j;
                const float rr = sigmoid_(ar[j] + br), ii = sigmoid_(ai[j] + bi), la = -8.0f * rr * sp, a = __expf(la);
                AA[t * 65 + d] = a; BB[t * 65 + d] = __builtin_amdgcn_sqrtf(neg_expm1_(2.0f * la)) * ii * XC[t * 65 + d];
            }
        }
    }
    __syncthreads();
    const int c = tid & 63, sg = tid >> 6;
    {
        float P = 1.f, H = 0.f;
#pragma unroll
        for (int j = 0; j < 8; ++j) { const int t = sg * 8 + j; const float a = AA[t * 65 + c]; H = a * H + BB[t * 65 + c]; P *= a; }
        SEG[(sg * 64 + c) * 2] = P; SEG[(sg * 64 + c) * 2 + 1] = H;
        if (mode == 1) {
#pragma unroll
            for (int k = 0; k < 2; ++k) *(f32x4*)(SUM + (tid + 512 * k) * 4) = sm4[k];
        }
    }
    __syncthreads();
    if (mode == 1) {
        if (tid < 64) { float h = 0.f; for (int m = 0; m < n; ++m) h = SUM[m * 128 + c * 2] * h + SUM[m * 128 + c * 2 + 1]; H0[c] = h; }
        __syncthreads();
    }
    float hin = mode == 1 ? H0[c] : 0.f;
    for (int s = 0; s < sg; ++s) hin = SEG[(s * 64 + c) * 2] * hin + SEG[(s * 64 + c) * 2 + 1];
    if (mode == 0) {
        if (sg == 7) { float pt = 1.f;
#pragma unroll
            for (int s = 0; s < 8; ++s) pt *= SEG[(s * 64 + c) * 2];
            const float hc = SEG[(7 * 64 + c) * 2] * hin + SEG[(7 * 64 + c) * 2 + 1];
            float* dst = rgsum + ((size_t)(b * 32 + n) * 512 + ch0 + c) * 2; dst[0] = pt; dst[1] = hc; }
    } else {
        float h = hin;
#pragma unroll
        for (int j = 0; j < 8; ++j) { const int t = sg * 8 + j; h = AA[t * 65 + c] * h + BB[t * 65 + c];
            const size_t ro = (size_t)(row0 + t) * NPROJ; const float z = bf2f(proj[ro + COL_RGZ + ch0 + c]);
            proj[ro + YOFF + ch0 + c] = f2bf(h * silu_(z)); }
    }
    __syncthreads();
}

__device__ __forceinline__ void rg_unit2(unsigned char* lds, const Params& p, int l, int b, int n, int mode) {
    const int tid = opaque_tid(), lane = tid & 63, nb = __builtin_amdgcn_readfirstlane(tid >> 6), r = lane & 15, q = lane >> 4;
    unsigned char* wl = lds + nb * 18432;
    bf16_t* XC16 = (bf16_t*)wl; float* AB = (float*)(wl + 10240);
    bf16_t* proj = (bf16_t*)(p.ws + WS_PROJ); float* rgsum = (float*)(p.ws + WS_RGSUM);
    const int row0 = b * SEQ + n * 64, ch0 = nb * 64;
    bf16x8 WF[2][4][2];
    {
        const bf16_t* wsrc = (const bf16_t*)(p.ws + WS_WT16);
#pragma unroll
        for (int g = 0; g < 2; ++g)
#pragma unroll
            for (int dblk = 0; dblk < 4; ++dblk)
#pragma unroll
                for (int ks = 0; ks < 2; ++ks) WF[g][dblk][ks] = *(const bf16x8*)(wsrc + ((size_t)((l * 2 + g) * 8 + nb) * 64 + dblk * 16 + r) * 64 + ks * 32 + q * 8);
    }
    float pbr[4], pbi[4], plam[4];
#pragma unroll
    for (int dblk = 0; dblk < 4; ++dblk) { const int ch = ch0 + dblk * 16 + r; pbr[dblk] = p.rg_gate_b[l * 1024 + ch]; pbi[dblk] = p.rg_gate_b[l * 1024 + 512 + ch]; plam[dblk] = p.rg_lambda[l * 512 + ch]; }
    float h0 = 0.f;
    if (mode == 1) {
        const float* sm = rgsum + ((size_t)(b * 32) * 512 + ch0 + lane) * 2;
#pragma unroll
        for (int mb = 0; mb < 2; ++mb) {
            f32x2v ab[16];
#pragma unroll
            for (int k = 0; k < 16; ++k) { const int m = mb * 16 + k; ab[k] = (f32x2v){1.f, 0.f}; if (m < n) ab[k] = *(const f32x2v*)(sm + (size_t)m * 1024); }
#pragma unroll
            for (int k = 0; k < 16; ++k) h0 = ab[k].x * h0 + ab[k].y;
        }
    }
    {
        const int ch = ch0 + lane;
        const float* cw = p.rg_conv_w + l * 4 * 512 + ch; const float w0 = cw[0], w1 = cw[512], w2 = cw[1024], w3 = cw[1536], cb = p.rg_conv_b[l * 512 + ch];
        const bf16_t* src = proj + (size_t)row0 * NPROJ + COL_RGX + ch;
        float xm3 = 0.f, xm2 = 0.f, xm1 = 0.f;
        if (n > 0) { xm3 = bf2f(src[-3 * NPROJ]); xm2 = bf2f(src[-2 * NPROJ]); xm1 = bf2f(src[-1 * NPROJ]); }
#pragma unroll
        for (int t = 0; t < 64; ++t) { const float x = bf2f(src[(size_t)t * NPROJ]); XC16[t * 80 + lane] = f2bf(w0 * xm3 + w1 * xm2 + w2 * xm1 + w3 * x + cb); xm3 = xm2; xm2 = xm1; xm1 = x; }
    }
    bf16x8 AF[4][2];
#pragma unroll
    for (int tt = 0; tt < 4; ++tt)
#pragma unroll
        for (int ks = 0; ks < 2; ++ks) AF[tt][ks] = *(const bf16x8*)(XC16 + (tt * 16 + r) * 80 + ks * 32 + q * 8);
#pragma unroll
    for (int dblk = 0; dblk < 4; ++dblk) {
        const int d = dblk * 16 + r, ch = ch0 + d;
        const float br = pbr[dblk], bi = pbi[dblk], sp = softplus_(-plam[dblk]);
#pragma unroll
        for (int tt = 0; tt < 4; ++tt) {
            f32x4 ar = {0.f, 0.f, 0.f, 0.f}, ai = {0.f, 0.f, 0.f, 0.f};
#pragma unroll
            for (int ks = 0; ks < 2; ++ks) { ar = mfma16(AF[tt][ks], WF[0][dblk][ks], ar); ai = mfma16(AF[tt][ks], WF[1][dblk][ks], ai); }
#pragma unroll
            for (int j = 0; j < 4; ++j) {
                const int t = tt * 16 + q * 4 + j;
                const float rr = sigmoid_(ar[j] + br), ii = sigmoid_(ai[j] + bi), la = -8.0f * rr * sp;
                f32x2v ab; ab.x = __expf(la);
                const float x2 = 2.0f * la, ser = -x2 * (1.f + x2 * (0.5f + x2 * (0.16666667f + x2 * (0.041666668f + x2 * (0.0083333338f + x2 * 0.0013888889f))))), big = 1.f - ab.x * ab.x;
                ab.y = __builtin_amdgcn_sqrtf(x2 > -0.25f ? ser : big) * ii * bf2f(XC16[t * 80 + d]);
                *(f32x2v*)(AB + (t * 16 + r) * 2) = ab;
            }
        }
        const float hc = __shfl(h0, dblk * 16 + r);
        if (lane < 16) {
            float h = hc, P = 1.f;
#pragma unroll 8
            for (int t = 0; t < 64; ++t) { const f32x2v ab = *(const f32x2v*)(AB + (t * 16 + lane) * 2); h = ab.x * h + ab.y; P *= ab.x; if (mode == 1) AB[(t * 16 + lane) * 2] = h; }
            if (mode == 0) { float* dst = rgsum + ((size_t)(b * 32 + n) * 512 + ch) * 2; dst[0] = P; dst[1] = h; }
        }
        if (mode == 1) {
#pragma unroll
            for (int i = 0; i < 16; ++i) { const int t = i * 4 + q; const float h = AB[(t * 16 + r) * 2];
                const size_t ro = (size_t)(row0 + t) * NPROJ; const float z = bf2f(proj[ro + COL_RGZ + ch]);
                proj[ro + YOFF + ch] = f2bf(h * silu_(z)); }
        }
    }
    __syncthreads();
}

__device__ __forceinline__ void ml_m1(unsigned char* lds, const Params& p, int l, int b, int h, int n) {
    const int tid = opaque_tid(), lane = tid & 63, wid = tid >> 6, r = lane & 15, q = lane >> 4;
    bf16_t* Q16 = (bf16_t*)lds; bf16_t* K16 = (bf16_t*)(lds + 17408); bf16_t* VT16 = (bf16_t*)(lds + 34816); bf16_t* KTw = (bf16_t*)(lds + 53248); bf16_t* SP16 = (bf16_t*)(lds + 71680);
    float* LI = (float*)(lds + 80896); float* BC = LI + 64; float* ML = BC + 64; float* WK = ML + 64; float* DENP = WK + 64; float* MISC = DENP + 256;
    bf16_t* proj = (bf16_t*)(p.ws + WS_PROJ); const float* gates = (const float*)(p.ws + WS_GATES);
    unsigned char* rec = p.ws + WS_MLREC + (size_t)((b * 4 + h) * 32 + n) * MLREC_BYTES;
    const int row0 = b * SEQ + n * 64;
    if (wid == 0) {
        const int t = lane; const float* gp = gates + (size_t)(row0 + t) * 16;
        const float li = gp[h] + p.ml_gate_b[l * 8 + h], fp = gp[4 + h] + p.ml_gate_b[l * 8 + 4 + h];
        const float lf = -softplus_(-fp), bc = wave_incl_sum(lf, lane), pm = wave_incl_max(li - bc, lane), ml = bc + pm;
        const float g = __builtin_bit_cast(float, __builtin_amdgcn_readlane(__builtin_bit_cast(int, bc), 63)), ws = g - bc + li, mw = wave_max(ws);
        LI[t] = li; BC[t] = bc; ML[t] = ml; WK[t] = __expf(ws - mw);
        if (t == 0) { MISC[0] = g; MISC[1] = mw; }
    }
    if (tid >= 256) DENP[tid - 256] = 0.f;
    u32x4 kreg[2];
#pragma unroll
    for (int i = 0; i < 2; ++i) {
        const int wv = (tid >> 6) + 8 * i, rw = (wv & 3) * 16 + (lane & 15), sg = (wv >> 2) * 4 + (lane >> 4); const bf16_t* base = proj + (size_t)(row0 + rw) * NPROJ + h * 128 + sg * 8;
        const u32x4 qv = *(const u32x4*)(base + COL_MLQ), kv = *(const u32x4*)(base + COL_MLK), vv = *(const u32x4*)(base + COL_MLV);
        *(u32x4*)(Q16 + rw * 136 + sg * 8) = qv; *(u32x4*)(K16 + rw * 136 + sg * 8) = kv; kreg[i] = kv;
#pragma unroll
        for (int e = 0; e < 8; ++e) VT16[(sg * 8 + e) * 72 + rw] = (bf16_t)(vv[e >> 1] >> ((e & 1) * 16));
    }
    __syncthreads();
#pragma unroll
    for (int i = 0; i < 2; ++i) {
        const int wv = (tid >> 6) + 8 * i, rw = (wv & 3) * 16 + (lane & 15), sg = (wv >> 2) * 4 + (lane >> 4); const float wk = WK[rw];
#pragma unroll
        for (int e = 0; e < 8; ++e) KTw[(sg * 8 + e) * 72 + rw] = f2bf(bf2f((bf16_t)(kreg[i][e >> 1] >> ((e & 1) * 16))) * wk);
    }
    {
        const int tt = wid >> 1;
#pragma unroll
        for (int hf = 0; hf < 2; ++hf) {
            const int st = (wid & 1) * 2 + hf, s = st * 16 + r;
            if (st > tt) {
#pragma unroll
                for (int j = 0; j < 4; ++j) SP16[(tt * 16 + q * 4 + j) * 72 + s] = 0;
                continue;
            }
            f32x4 acc = {0.f, 0.f, 0.f, 0.f};
#pragma unroll
            for (int ks = 0; ks < 4; ++ks) acc = mfma16(*(const bf16x8*)(Q16 + (tt * 16 + r) * 136 + ks * 32 + q * 8), *(const bf16x8*)(K16 + (st * 16 + r) * 136 + ks * 32 + q * 8), acc);
            const float bs = BC[s], lis = LI[s];
#pragma unroll
            for (int j = 0; j < 4; ++j) {
                const int t = tt * 16 + q * 4 + j;
                const float sp = s <= t ? acc[j] * QSCALE * __expf(BC[t] - bs + lis - ML[t]) : 0.f;
                const float v = sum16_dpp(sp);
                if (r == 0) DENP[t * 4 + st] = v;
                SP16[t * 72 + s] = f2bf(sp);
            }
        }
    }
    __syncthreads();
    {
        const int eb = wid; bf16x8 Bf[2];
#pragma unroll
        for (int ks = 0; ks < 2; ++ks) Bf[ks] = *(const bf16x8*)(VT16 + (eb * 16 + r) * 72 + ks * 32 + q * 8);
        bf16_t* inum = (bf16_t*)rec; bf16_t* gate = (bf16_t*)(rec + 16384);
#pragma unroll
        for (int tt = 0; tt < 4; ++tt) {
            f32x4 acc = {0.f, 0.f, 0.f, 0.f};
#pragma unroll
            for (int ks = 0; ks < 2; ++ks) acc = mfma16(*(const bf16x8*)(SP16 + (tt * 16 + r) * 72 + ks * 32 + q * 8), Bf[ks], acc);
            u32x2 w; w.x = pack2(acc[0], acc[1]); w.y = pack2(acc[2], acc[3]);
            *(u32x2*)(inum + ((eb * 4 + tt) * 64 + lane) * 4) = w;
            float gv[4];
#pragma unroll
            for (int j = 0; j < 4; ++j) { const size_t ro = (size_t)(row0 + tt * 16 + q * 4 + j) * NPROJ + h * 128 + eb * 16 + r;
                gv[j] = sigmoid_(bf2f(proj[ro + COL_MLO])) * silu_(bf2f(proj[ro + COL_MLZ])); }
#pragma unroll
            for (int j = 0; j < 4; ++j) gate[(tt * 16 + q * 4 + j) * 128 + eb * 16 + r] = f2bf(gv[j]);
        }
#pragma unroll
        for (int dblk = 0; dblk < 8; ++dblk) {
            f32x4 acc = {0.f, 0.f, 0.f, 0.f};
#pragma unroll
            for (int ks = 0; ks < 2; ++ks) acc = mfma16(*(const bf16x8*)(KTw + (dblk * 16 + r) * 72 + ks * 32 + q * 8), Bf[ks], acc);
            u32x2 w; w.x = pack2(acc[0], acc[1]); w.y = pack2(acc[2], acc[3]);
            const int ti = eb * 8 + dblk;
            bf16_t* dst = proj + (size_t)(row0 + ti) * NPROJ + h * 128 + (lane < 32 ? COL_MLK + lane * 4 : COL_MLV + (lane - 32) * 4);
            *(u32x2*)dst = w;
        }
    }
    float* sc = (float*)(rec + 32768);
    if (tid < 64) { const int t = tid; sc[t] = ML[t]; sc[64 + t] = BC[t]; sc[128 + t] = (DENP[t * 4] + DENP[t * 4 + 1]) + (DENP[t * 4 + 2] + DENP[t * 4 + 3]); }
    else if (tid < 192) { const int d = tid - 64; float s = 0.f;
#pragma unroll
        for (int i = 0; i < 8; ++i) { const u32x4 w = *(const u32x4*)(KTw + d * 72 + i * 8);
#pragma unroll
            for (int k = 0; k < 4; ++k) s += bflo(w[k]) + bfhi(w[k]); }
        sc[192 + d] = s; }
    else if (tid == 192) { sc[320] = MISC[0]; sc[321] = MISC[1]; }
    __syncthreads();
}

__device__ __forceinline__ void ml_m1c(unsigned char* lds, const Params& p, int l, int b, int h, int n) {
    const int tid = opaque_tid(), t8 = tid & 255, lane = tid & 63, w4 = (tid >> 6) & 3, r = lane & 15, q = lane >> 4;
    unsigned char* hl = lds + (tid >> 8) * 79872;
    bf16_t* Q16 = (bf16_t*)hl; bf16_t* K16 = (bf16_t*)(hl + 17408); bf16_t* VT16 = (bf16_t*)(hl + 34816); bf16_t* KTw = (bf16_t*)(hl + 55296); bf16_t* SP16 = (bf16_t*)hl;
    float* LI = (float*)(hl + 75776); float* BC = LI + 64; float* ML = BC + 64; float* WK = ML + 64; float* DENP = WK + 64; float* MISC = DENP + 256;
    bf16_t* proj = (bf16_t*)(p.ws + WS_PROJ); const float* gates = (const float*)(p.ws + WS_GATES);
    unsigned char* rec = p.ws + WS_MLREC + (size_t)((b * 4 + h) * 32 + n) * MLREC_BYTES;
    const int row0 = b * SEQ + n * 64;
    if (w4 == 0) {
        const int t = lane; const float* gp = gates + (size_t)(row0 + t) * 16;
        const float li = gp[h] + p.ml_gate_b[l * 8 + h], fp = gp[4 + h] + p.ml_gate_b[l * 8 + 4 + h];
        const float lf = -softplus_(-fp), bc = wave_incl_sum(lf, lane), pm = wave_incl_max(li - bc, lane), ml = bc + pm;
        const float g = __builtin_bit_cast(float, __builtin_amdgcn_readlane(__builtin_bit_cast(int, bc), 63)), ws = g - bc + li, mw = wave_max(ws);
        LI[t] = li; BC[t] = bc; ML[t] = ml; WK[t] = __expf(ws - mw);
        if (t == 0) { MISC[0] = g; MISC[1] = mw; }
    }
    DENP[t8] = 0.f;
    u32x4 go[2][2], gz[2][2];
#pragma unroll
    for (int k2 = 0; k2 < 2; ++k2) { const int task = t8 + 256 * k2, t = task >> 3, grp = task & 7; const bf16_t* gbase = proj + (size_t)(row0 + t) * NPROJ + h * 128 + grp * 16;
        go[k2][0] = *(const u32x4*)(gbase + COL_MLO); go[k2][1] = *(const u32x4*)(gbase + COL_MLO + 8); gz[k2][0] = *(const u32x4*)(gbase + COL_MLZ); gz[k2][1] = *(const u32x4*)(gbase + COL_MLZ + 8); }
    u32x4 kreg[4];
#pragma unroll
    for (int i = 0; i < 4; ++i) {
        const int wv = w4 + 4 * i, rw = (wv & 3) * 16 + (lane & 15), sg = (wv >> 2) * 4 + (lane >> 4); const bf16_t* base = proj + (size_t)(row0 + rw) * NPROJ + h * 128 + sg * 8;
        const u32x4 qv = *(const u32x4*)(base + COL_MLQ), kv = *(const u32x4*)(base + COL_MLK), vv = *(const u32x4*)(base + COL_MLV);
        *(u32x4*)(Q16 + rw * 136 + sg * 8) = qv; *(u32x4*)(K16 + rw * 136 + sg * 8) = kv; kreg[i] = kv;
#pragma unroll
        for (int e = 0; e < 8; ++e) VT16[(sg * 8 + e) * 80 + rw] = (bf16_t)(vv[e >> 1] >> ((e & 1) * 16));
    }
    __syncthreads();
    {
        bf16_t* gate = (bf16_t*)(rec + 16384);
#pragma unroll
        for (int k2 = 0; k2 < 2; ++k2) { const int task = t8 + 256 * k2, t = task >> 3, grp = task & 7;
#pragma unroll
            for (int i = 0; i < 2; ++i) { u32x4 w;
#pragma unroll
                for (int k = 0; k < 4; ++k) {
                    const float o0 = bflo(go[k2][i][k]), o1 = bfhi(go[k2][i][k]), z0 = bflo(gz[k2][i][k]), z1 = bfhi(gz[k2][i][k]);
                    w[k] = pack2(z0 * __builtin_amdgcn_rcpf((1.f + __expf(-o0)) * (1.f + __expf(-z0))), z1 * __builtin_amdgcn_rcpf((1.f + __expf(-o1)) * (1.f + __expf(-z1)))); }
                *(u32x4*)(gate + t * 128 + grp * 16 + i * 8) = w; } }
    }
#pragma unroll
    for (int i = 0; i < 4; ++i) {
        const int wv = w4 + 4 * i, rw = (wv & 3) * 16 + (lane & 15), sg = (wv >> 2) * 4 + (lane >> 4); const float wk = WK[rw];
#pragma unroll
        for (int e = 0; e < 8; ++e) KTw[(sg * 8 + e) * 80 + rw] = f2bf(bf2f((bf16_t)(kreg[i][e >> 1] >> ((e & 1) * 16))) * wk);
    }
    float spv[4][4];
    {
        const int tt = w4;
#pragma unroll
        for (int st = 0; st < 4; ++st) {
            const int s = st * 16 + r;
#pragma unroll
            for (int j = 0; j < 4; ++j) spv[st][j] = 0.f;
            if (st <= tt) {
                f32x4 acc = {0.f, 0.f, 0.f, 0.f};
#pragma unroll
                for (int ks = 0; ks < 4; ++ks) acc = mfma16(*(const bf16x8*)(Q16 + (tt * 16 + r) * 136 + ks * 32 + q * 8), *(const bf16x8*)(K16 + (st * 16 + r) * 136 + ks * 32 + q * 8), acc);
                const float bs = BC[s], lis = LI[s];
#pragma unroll
                for (int j = 0; j < 4; ++j) {
                    const int t = tt * 16 + q * 4 + j;
                    const float sp = s <= t ? acc[j] * QSCALE * __expf(BC[t] - bs + lis - ML[t]) : 0.f;
                    const float v = sum16_dpp(sp);
                    if (r == 0) DENP[t * 4 + st] = v;
                    spv[st][j] = sp;
                }
            }
        }
    }
    __syncthreads();
#pragma unroll
    for (int st = 0; st < 4; ++st)
#pragma unroll
        for (int j = 0; j < 4; ++j) SP16[(w4 * 16 + q * 4 + j) * 80 + st * 16 + r] = f2bf(spv[st][j]);
    __syncthreads();
#pragma unroll
    for (int e2 = 0; e2 < 2; ++e2) {
        const int eb = w4 * 2 + e2; bf16x8 Bf[2];
#pragma unroll
        for (int ks = 0; ks < 2; ++ks) Bf[ks] = *(const bf16x8*)(VT16 + (eb * 16 + r) * 80 + ks * 32 + q * 8);
        bf16_t* inum = (bf16_t*)rec;
#pragma unroll
        for (int tt = 0; tt < 4; ++tt) {
            f32x4 acc = {0.f, 0.f, 0.f, 0.f};
#pragma unroll
            for (int ks = 0; ks < 2; ++ks) acc = mfma16(*(const bf16x8*)(SP16 + (tt * 16 + r) * 80 + ks * 32 + q * 8), Bf[ks], acc);
            u32x2 w; w.x = pack2(acc[0], acc[1]); w.y = pack2(acc[2], acc[3]);
            *(u32x2*)(inum + ((eb * 4 + tt) * 64 + lane) * 4) = w;
        }
#pragma unroll
        for (int dblk = 0; dblk < 8; ++dblk) {
            f32x4 acc = {0.f, 0.f, 0.f, 0.f};
#pragma unroll
            for (int ks = 0; ks < 2; ++ks) acc = mfma16(*(const bf16x8*)(KTw + (dblk * 16 + r) * 80 + ks * 32 + q * 8), Bf[ks], acc);
            u32x2 w; w.x = pack2(acc[0], acc[1]); w.y = pack2(acc[2], acc[3]);
            const int ti = eb * 8 + dblk;
            bf16_t* dst = proj + (size_t)(row0 + ti) * NPROJ + h * 128 + (lane < 32 ? COL_MLK + lane * 4 : COL_MLV + (lane - 32) * 4);
            *(u32x2*)dst = w;
        }
    }
    float* sc = (float*)(rec + 32768);
    if (t8 < 64) { const int t = t8; sc[t] = ML[t]; sc[64 + t] = BC[t]; sc[128 + t] = (DENP[t * 4] + DENP[t * 4 + 1]) + (DENP[t * 4 + 2] + DENP[t * 4 + 3]); }
    else if (t8 < 192) { const int d = t8 - 64; float s = 0.f;
#pragma unroll
        for (int i = 0; i < 8; ++i) { const u32x4 w = *(const u32x4*)(KTw + d * 80 + i * 8);
#pragma unroll
            for (int k = 0; k < 4; ++k) s += bflo(w[k]) + bfhi(w[k]); }
        sc[192 + d] = s; }
    else if (t8 == 192) { sc[320] = MISC[0]; sc[321] = MISC[1]; }
    __syncthreads();
}

#ifndef GD_VALU_SOLVE
#define GD_VALU_SOLVE 0
#endif
__device__ __forceinline__ void gd_m1(unsigned char* lds, const Params& p, int l, int b, int h, int n) {
    const int tid = opaque_tid(), lane = tid & 63, wid = tid >> 6, r = lane & 15, q = lane >> 4;
    bf16_t* Q16 = (bf16_t*)lds; bf16_t* K16 = (bf16_t*)(lds + 17408); float* MM = (float*)(lds + 34816);
    float* BETA = (float*)(lds + 51200); float* GC = BETA + 64; float* EGC = GC + 64; float* EKD = EGC + 64; float* SSP = EKD + 64; float* RN = SSP + 256;
    bf16_t* proj = (bf16_t*)(p.ws + WS_PROJ); const float* gates = (const float*)(p.ws + WS_GATES);
    unsigned char* rec = p.ws + WS_GDREC + (size_t)((b * 4 + h) * 32 + n) * GDREC_BYTES;
    const int row0 = b * SEQ + n * 64, sel = tid >> 7, ch = tid & 127;
    float* VS = (float*)lds;
    bf16_t* MP16 = (bf16_t*)(lds + 120320);
    bf16_t* TP16 = (bf16_t*)(lds + 129536);
    for (int i = tid; i < 896; i += 512) *(u32x4*)(lds + 120320 + i * 16) = (u32x4){0u, 0u, 0u, 0u};
    float val[64];
    if (sel < 3) {
        const float* cw = p.gd_conv_w + (size_t)l * 4 * 1536 + sel * 512 + h * 128 + ch; const float w0 = cw[0], w1 = cw[1536], w2 = cw[3072], w3 = cw[4608];
        const bf16_t* src = proj + (size_t)row0 * NPROJ + COL_GDQ + sel * 512 + h * 128 + ch;
        float xm3 = 0.f, xm2 = 0.f, xm1 = 0.f;
        if (n > 0) { xm3 = bf2f(src[-3 * NPROJ]); xm2 = bf2f(src[-2 * NPROJ]); xm1 = bf2f(src[-1 * NPROJ]); }
#pragma unroll
        for (int t = 0; t < 64; ++t) { const float x = bf2f(src[(size_t)t * NPROJ]); val[t] = silu_(w0 * xm3 + w1 * xm2 + w2 * xm1 + w3 * x); xm3 = xm2; xm2 = xm1; xm1 = x; }
    } else {
#pragma unroll
        for (int t = 0; t < 64; ++t) val[t] = 0.f;
        if (wid == 7) {
            const int t = lane; const float* gp = gates + (size_t)(row0 + t) * 16;
            const float beta = sigmoid_(gp[12 + h]), g = -__expf(p.gd_a_log[l * 4 + h]) * softplus_(gp[8 + h] + p.gd_dt_bias[l * 4 + h]);
            const float gc = wave_incl_sum(g, lane), gl = __builtin_bit_cast(float, __builtin_amdgcn_readlane(__builtin_bit_cast(int, gc), 63));
            BETA[t] = beta; GC[t] = gc; EGC[t] = __expf(gc); EKD[t] = __expf(gl - gc);
        }
    }
    float* XS = (float*)(lds + 54272);
    if (sel < 2) {
#pragma unroll
        for (int t = 0; t < 64; ++t) XS[(sel * 64 + t) * 129 + ch] = val[t];
    }
    __syncthreads();
    {
        const int s2 = tid >> 8, t = (tid >> 2) & 63, part = tid & 3; const float* xr = XS + (s2 * 64 + t) * 129 + part * 32; float ss = 0.f;
#pragma unroll
        for (int i = 0; i < 32; ++i) ss += xr[i] * xr[i];
        ss += __shfl_xor(ss, 1); ss += __shfl_xor(ss, 2);
        if (part == 0) { float rn = rsqrtf(ss + EPS); if (s2 == 0) rn *= QSCALE; RN[s2 * 64 + t] = rn; }
    }
    __syncthreads();
    if (sel < 2) {
        bf16_t* dst = sel == 0 ? Q16 : K16;
#pragma unroll
        for (int t = 0; t < 64; ++t) { val[t] *= RN[sel * 64 + t]; dst[t * 136 + ch] = f2bf(val[t]); }
    }
    __syncthreads();
#pragma unroll
    for (int jj = 0; jj < 4; ++jj) {
        const int idx = wid * 4 + jj, which = idx >> 4, tt = (idx >> 2) & 3, st = idx & 3;
        if (which == 0 && st > tt) continue;
        f32x4 acc = {0.f, 0.f, 0.f, 0.f};
        if (st <= tt) {
            const bf16_t* Ab = which ? Q16 : K16;
#pragma unroll
            for (int ks = 0; ks < 4; ++ks) acc = mfma16(*(const bf16x8*)(Ab + (tt * 16 + r) * 136 + ks * 32 + q * 8), *(const bf16x8*)(K16 + (st * 16 + r) * 136 + ks * 32 + q * 8), acc);
        }
        const int s = st * 16 + r; const float gcs = GC[s];
        bf16_t* aq = (bf16_t*)(rec + 49152);
#pragma unroll
        for (int j = 0; j < 4; ++j) {
            const int t = tt * 16 + q * 4 + j;
            if (which == 0) { const float mv = s < t ? BETA[t] * acc[j] * __expf(GC[t] - gcs) : 0.f; MM[t * 64 + s] = mv; MP16[t * 72 + (st >> 1) * 32 + permpos(s & 31)] = f2bf(mv); }
            else aq[t * 64 + (st >> 1) * 32 + permpos(s & 31)] = f2bf(s <= t ? acc[j] * __expf(GC[t] - gcs) : 0.f);
        }
    }
    __syncthreads();
    const int pos = (ch & ~31) + permpos(ch & 31);
    if (sel == 0) { bf16_t* qd = (bf16_t*)(rec + 16384);
#pragma unroll
        for (int t = 0; t < 64; ++t) qd[t * 128 + pos] = f2bf(val[t] * EGC[t]); }
    if (sel == 1) {
        bf16_t* kd = (bf16_t*)(rec + 32768) + ch * 64;
#pragma unroll
        for (int p4 = 0; p4 < 16; ++p4) {
            const int pp = (p4 * 4) & 31, s0 = ((p4 * 4) >> 5) * 32 + ((pp >> 2) & 1) * 16 + (pp >> 3) * 4;
            u32x2 w; w.x = pack2(val[s0] * EKD[s0], val[s0 + 1] * EKD[s0 + 1]); w.y = pack2(val[s0 + 2] * EKD[s0 + 2], val[s0 + 3] * EKD[s0 + 3]);
            *(u32x2*)(kd + p4 * 4) = w;
        }
#pragma unroll
        for (int t = 0; t < 64; ++t) val[t] *= BETA[t] * EGC[t];
    }
#if GD_VALU_SOLVE
    if (sel == 2) {
#pragma unroll
        for (int t = 0; t < 64; ++t) val[t] *= BETA[t];
    }
    if (sel == 1 || sel == 2) {
#pragma unroll
        for (int t = 1; t < 64; ++t) {
            float a = val[t];
#pragma unroll
            for (int s4 = 0; s4 < (t + 3) / 4; ++s4) { const f32x4 m = *(const f32x4*)(MM + t * 64 + s4 * 4);
                a -= m[0] * val[s4 * 4]; a -= m[1] * val[s4 * 4 + 1]; a -= m[2] * val[s4 * 4 + 2]; a -= m[3] * val[s4 * 4 + 3]; }
            val[t] = a;
        }
    }
    if (sel == 2) { bf16_t* up = (bf16_t*)(rec + 57344); const int eb = ch >> 4, c = ch & 15;
#pragma unroll
        for (int t = 0; t < 64; ++t) up[((eb * 4 + (t >> 4)) * 64 + ((t >> 2) & 3) * 16 + c) * 4 + (t & 3)] = f2bf(val[t]); }
    if (sel == 1) { bf16_t* wp = (bf16_t*)rec;
#pragma unroll
        for (int t = 0; t < 64; ++t) wp[t * 128 + pos] = f2bf(val[t]); }
    if (tid == 511) *(float*)(rec + 73728) = GC[63];
    __syncthreads();
#else
    (void)r; (void)q;
    if (sel == 2) {
#pragma unroll
        for (int t = 0; t < 64; ++t) VS[t * 136 + ch] = val[t];
    }
    if (tid < 64) {
        const int bi = tid >> 4, c = tid & 15; float x[16];
#pragma unroll
        for (int t = 0; t < 16; ++t) x[t] = (t == c) ? 1.f : 0.f;
#pragma unroll
        for (int t = 1; t < 16; ++t) { float a = x[t];
#pragma unroll
            for (int s2 = 0; s2 < t; ++s2) a -= MM[(bi * 16 + t) * 64 + bi * 16 + s2] * x[s2];
            x[t] = a; }
#pragma unroll
        for (int t = 0; t < 16; ++t) TP16[(bi * 16 + t) * 40 + ((c >> 2) & 3) * 8 + (c & 3)] = f2bf(x[t]);
    }
    __syncthreads();
    {
#pragma unroll
        for (int ci = 0; ci < 2; ++ci) {
            const int ct = wid * 2 + ci, c = ct * 16 + r;
            f32x4 X[4];
#pragma unroll
            for (int bi = 0; bi < 4; ++bi) {
                f32x4 z = {0.f, 0.f, 0.f, 0.f};
#pragma unroll
                for (int kk = 0; kk < 2; ++kk) {
                    if (2 * kk < bi) {
                        const f32x4 zero = {0.f, 0.f, 0.f, 0.f};
                        const bf16x8 Bop = pack_b(X[2 * kk], (2 * kk + 1 < bi) ? X[2 * kk + 1] : zero);
                        z = mfma16(*(const bf16x8*)(MP16 + (bi * 16 + r) * 72 + kk * 32 + q * 8), Bop, z);
                    }
                }
#pragma unroll
                for (int j = 0; j < 4; ++j) { const int t = bi * 16 + q * 4 + j;
                    const float rv = ct < 8 ? VS[t * 136 + c] * BETA[t] : XS[(64 + t) * 129 + (c - 128)] * RN[64 + t] * BETA[t] * EGC[t];
                    z[j] = rv - z[j]; }
                const f32x4 zero = {0.f, 0.f, 0.f, 0.f};
                X[bi] = mfma16(*(const bf16x8*)(TP16 + (bi * 16 + r) * 40 + q * 8), pack_b(z, zero), zero);
            }
            if (ct < 8) { bf16_t* up = (bf16_t*)(rec + 57344);
#pragma unroll
                for (int bi = 0; bi < 4; ++bi) { u32x2 w; w.x = pack2(X[bi][0], X[bi][1]); w.y = pack2(X[bi][2], X[bi][3]); *(u32x2*)(up + ((ct * 4 + bi) * 64 + lane) * 4) = w; }
            } else { bf16_t* wp = (bf16_t*)rec; const int d = c - 128, pd = (d & ~31) + permpos(d & 31);
#pragma unroll
                for (int bi = 0; bi < 4; ++bi)
#pragma unroll
                    for (int j = 0; j < 4; ++j) wp[(bi * 16 + q * 4 + j) * 128 + pd] = f2bf(X[bi][j]); }
        }
    }
    if (tid == 511) *(float*)(rec + 73728) = GC[63];
    __syncthreads();
#endif
}

__device__ __forceinline__ void gd_m1b(unsigned char* lds, const Params& p, int l, int b, int h, int n) {
    const int tid = opaque_tid(), lane = tid & 63, wid = tid >> 6, r = lane & 15, q = lane >> 4;
    bf16_t* Q16 = (bf16_t*)lds; bf16_t* K16 = (bf16_t*)(lds + 17408);
    float* MMD = (float*)(lds + 34816);
    float* BETA = (float*)(lds + 38912); float* GC = BETA + 64; float* EGC = GC + 64; float* EKD = EGC + 64; float* RN = EKD + 64;
    float* XS = (float*)(lds + 41472);
    bf16_t* MP16 = (bf16_t*)(lds + 140544);
    bf16_t* TP16 = (bf16_t*)(lds + 149760);
    bf16_t* proj = (bf16_t*)(p.ws + WS_PROJ); const float* gates = (const float*)(p.ws + WS_GATES);
    unsigned char* rec = p.ws + WS_GDREC + (size_t)((b * 4 + h) * 32 + n) * GDREC_BYTES;
    const int row0 = b * SEQ + n * 64;
    for (int i = tid; i < 896; i += 512) *(u32x4*)(lds + 140544 + i * 16) = (u32x4){0u, 0u, 0u, 0u};
    if (tid < 384) {
        const int ts = tid / 48, cg = tid - ts * 48, sel = cg >> 4, ch8 = (cg & 15) * 8, t0 = ts * 8;
        const float* cw = p.gd_conv_w + (size_t)l * 4 * 1536 + sel * 512 + h * 128 + ch8;
        f32x4 wv[4][2];
#pragma unroll
        for (int k = 0; k < 4; ++k) { wv[k][0] = *(const f32x4*)(cw + k * 1536); wv[k][1] = *(const f32x4*)(cw + k * 1536 + 4); }
        const bf16_t* src = proj + (size_t)(row0 + t0 - 3) * NPROJ + COL_GDQ + sel * 512 + h * 128 + ch8;
        u32x4 xr[11];
#pragma unroll
        for (int i = 0; i < 11; ++i) { xr[i] = (u32x4){0u, 0u, 0u, 0u}; if (n > 0 || t0 - 3 + i >= 0) xr[i] = *(const u32x4*)(src + (size_t)i * NPROJ); }
#pragma unroll
        for (int j = 0; j < 8; ++j) {
            float* dst = XS + (sel * 64 + t0 + j) * 129 + ch8;
#pragma unroll
            for (int e = 0; e < 8; ++e) {
                float a = 0.f;
#pragma unroll
                for (int k = 0; k < 4; ++k) { const unsigned w = xr[j + k][e >> 1]; a += wv[k][e >> 2][e & 3] * ((e & 1) ? bfhi(w) : bflo(w)); }
                dst[e] = silu_(a);
            }
        }
    } else if (wid == 7) {
        const int t = lane; const float* gp = gates + (size_t)(row0 + t) * 16;
        const float beta = sigmoid_(gp[12 + h]), g = -__expf(p.gd_a_log[l * 4 + h]) * softplus_(gp[8 + h] + p.gd_dt_bias[l * 4 + h]);
        const float gc = wave_incl_sum(g, lane), gl = __builtin_bit_cast(float, __builtin_amdgcn_readlane(__builtin_bit_cast(int, gc), 63));
        BETA[t] = beta; GC[t] = gc; EGC[t] = __expf(gc); EKD[t] = __expf(gl - gc);
    }
    __syncthreads();
    {
        const int s2 = tid >> 8, t = (tid >> 2) & 63, part = tid & 3; const float* xr = XS + (s2 * 64 + t) * 129 + part * 32; float v[32]; float ss = 0.f;
#pragma unroll
        for (int i = 0; i < 32; ++i) { v[i] = xr[i]; ss += v[i] * v[i]; }
        ss = sum4_dpp(ss);
        float rn = rsqrtf(ss + EPS); if (s2 == 0) rn *= QSCALE;
        if (part == 0) RN[s2 * 64 + t] = rn;
        bf16_t* dst = (s2 ? K16 : Q16) + t * 136 + part * 32;
#pragma unroll
        for (int i = 0; i < 4; ++i) { u32x4 w; w.x = pack2(v[i * 8] * rn, v[i * 8 + 1] * rn); w.y = pack2(v[i * 8 + 2] * rn, v[i * 8 + 3] * rn); w.z = pack2(v[i * 8 + 4] * rn, v[i * 8 + 5] * rn); w.w = pack2(v[i * 8 + 6] * rn, v[i * 8 + 7] * rn);
            *(u32x4*)(dst + i * 8) = w; }
    }
    __syncthreads();
#pragma unroll
    for (int jj = 0; jj < 4; ++jj) {
        const int idx = wid * 4 + jj, which = idx >> 4, tt = (idx >> 2) & 3, st = idx & 3;
        if (which == 0 && st > tt) continue;
        f32x4 acc = {0.f, 0.f, 0.f, 0.f};
        if (st <= tt) {
            const bf16_t* Ab = which ? Q16 : K16;
#pragma unroll
            for (int ks = 0; ks < 4; ++ks) acc = mfma16(*(const bf16x8*)(Ab + (tt * 16 + r) * 136 + ks * 32 + q * 8), *(const bf16x8*)(K16 + (st * 16 + r) * 136 + ks * 32 + q * 8), acc);
        }
        const int s = st * 16 + r; const float gcs = GC[s];
        bf16_t* aq = (bf16_t*)(rec + 49152);
#pragma unroll
        for (int j = 0; j < 4; ++j) {
            const int t = tt * 16 + q * 4 + j;
            if (which == 0) { const float mv = s < t ? BETA[t] * acc[j] * __expf(GC[t] - gcs) : 0.f; if (st == tt) MMD[(tt * 16 + q * 4 + j) * 16 + r] = mv; MP16[t * 72 + (st >> 1) * 32 + permpos(s & 31)] = f2bf(mv); }
            else aq[t * 64 + (st >> 1) * 32 + permpos(s & 31)] = f2bf(s <= t ? acc[j] * __expf(GC[t] - gcs) : 0.f);
        }
    }
    __syncthreads();
    if (tid < 64) {
        const int bi = tid >> 4, c = tid & 15; float x[16];
#pragma unroll
        for (int t = 0; t < 16; ++t) x[t] = (t == c) ? 1.f : 0.f;
#pragma unroll
        for (int t = 1; t < 16; ++t) { float a = x[t];
#pragma unroll
            for (int s2 = 0; s2 < t; ++s2) a -= MMD[(bi * 16 + t) * 16 + s2] * x[s2];
            x[t] = a; }
#pragma unroll
        for (int t = 0; t < 16; ++t) TP16[(bi * 16 + t) * 40 + ((c >> 2) & 3) * 8 + (c & 3)] = f2bf(x[t]);
    }
    {
        const int t = tid >> 3, grp = tid & 7; const float* xr = XS + t * 129 + grp * 16; const float sc = RN[t] * EGC[t];
        bf16_t* qd = (bf16_t*)(rec + 16384) + t * 128 + (grp >> 1) * 32;
#pragma unroll
        for (int rr = 0; rr < 4; ++rr) { u32x2 w; w.x = pack2(xr[rr * 4] * sc, xr[rr * 4 + 1] * sc); w.y = pack2(xr[rr * 4 + 2] * sc, xr[rr * 4 + 3] * sc);
            *(u32x2*)(qd + (rr * 2 + (grp & 1)) * 4) = w; }
    }
    if (tid >= 128 && tid < 256) {
        const int d = tid - 128; bf16_t* kd = (bf16_t*)(rec + 32768) + d * 64;
#pragma unroll
        for (int p4 = 0; p4 < 16; ++p4) {
            const int pp = (p4 * 4) & 31, s0 = ((p4 * 4) >> 5) * 32 + ((pp >> 2) & 1) * 16 + (pp >> 3) * 4;
            float kv[4];
#pragma unroll
            for (int i = 0; i < 4; ++i) kv[i] = XS[(64 + s0 + i) * 129 + d] * RN[64 + s0 + i] * EKD[s0 + i];
            u32x2 w; w.x = pack2(kv[0], kv[1]); w.y = pack2(kv[2], kv[3]);
            *(u32x2*)(kd + p4 * 4) = w;
        }
    }
    if (tid == 511) *(float*)(rec + 73728) = GC[63];
    __syncthreads();
    {
#pragma unroll
        for (int ci = 0; ci < 2; ++ci) {
            const int ct = wid * 2 + ci, c = ct * 16 + r;
            f32x4 X[4];
#pragma unroll
            for (int bi = 0; bi < 4; ++bi) {
                f32x4 z = {0.f, 0.f, 0.f, 0.f};
#pragma unroll
                for (int kk = 0; kk < 2; ++kk) {
                    if (2 * kk < bi) {
                        const f32x4 zero = {0.f, 0.f, 0.f, 0.f};
                        const bf16x8 Bop = pack_b(X[2 * kk], (2 * kk + 1 < bi) ? X[2 * kk + 1] : zero);
                        z = mfma16(*(const bf16x8*)(MP16 + (bi * 16 + r) * 72 + kk * 32 + q * 8), Bop, z);
                    }
                }
#pragma unroll
                for (int j = 0; j < 4; ++j) { const int t = bi * 16 + q * 4 + j;
                    const float rv = ct < 8 ? XS[(128 + t) * 129 + c] * BETA[t] : XS[(64 + t) * 129 + (c - 128)] * RN[64 + t] * BETA[t] * EGC[t];
                    z[j] = rv - z[j]; }
                const f32x4 zero = {0.f, 0.f, 0.f, 0.f};
                X[bi] = mfma16(*(const bf16x8*)(TP16 + (bi * 16 + r) * 40 + q * 8), pack_b(z, zero), zero);
            }
            if (ct < 8) { bf16_t* up = (bf16_t*)(rec + 57344);
#pragma unroll
                for (int bi = 0; bi < 4; ++bi) { u32x2 w; w.x = pack2(X[bi][0], X[bi][1]); w.y = pack2(X[bi][2], X[bi][3]); *(u32x2*)(up + ((ct * 4 + bi) * 64 + lane) * 4) = w; }
            } else { bf16_t* wp = (bf16_t*)rec; const int d = c - 128, pd = (d & ~31) + permpos(d & 31);
#pragma unroll
                for (int bi = 0; bi < 4; ++bi)
#pragma unroll
                    for (int j = 0; j < 4; ++j) wp[(bi * 16 + q * 4 + j) * 128 + pd] = f2bf(X[bi][j]); }
        }
    }
    __syncthreads();
}

constexpr int GD_HALF_LDS = 79872;
__device__ __forceinline__ void gd_m1c(unsigned char* lds, const Params& p, int l, int b, int h, int n) {
    const int tid = opaque_tid(), t8 = tid & 255, lane = tid & 63, w4 = (tid >> 6) & 3, r = lane & 15, q = lane >> 4;
    unsigned char* hl = lds + (tid >> 8) * GD_HALF_LDS;
    bf16_t* Q16 = (bf16_t*)hl; bf16_t* K16 = (bf16_t*)(hl + 18432); bf16_t* V16 = (bf16_t*)(hl + 36864);
    float* MMD = (float*)(hl + 55296);
    float* BETA = (float*)(hl + 59392); float* GC = BETA + 64; float* EGC = GC + 64; float* EKD = EGC + 64; float* RN = EKD + 64;
    bf16_t* MP16 = (bf16_t*)(hl + 60928); bf16_t* TP16 = (bf16_t*)(hl + 71168);
    bf16_t* proj = (bf16_t*)(p.ws + WS_PROJ); const float* gates = (const float*)(p.ws + WS_GATES);
    unsigned char* rec = p.ws + WS_GDREC + (size_t)((b * 4 + h) * 32 + n) * GDREC_BYTES;
    const int row0 = b * SEQ + n * 64;
    for (int i = t8; i < 1024; i += 256) *(u32x4*)(hl + 60928 + i * 16) = (u32x4){0u, 0u, 0u, 0u};
    for (int task = t8; task < 384; task += 256) {
        const int ts = task / 48, cg = task - ts * 48, sel = cg >> 4, ch8 = (cg & 15) * 8, t0 = ts * 8;
        const float* cw = p.gd_conv_w + (size_t)l * 4 * 1536 + sel * 512 + h * 128 + ch8;
        f32x4 wv[4][2];
#pragma unroll
        for (int k = 0; k < 4; ++k) { wv[k][0] = *(const f32x4*)(cw + k * 1536); wv[k][1] = *(const f32x4*)(cw + k * 1536 + 4); }
        const bf16_t* src = proj + (size_t)(row0 + t0 - 3) * NPROJ + COL_GDQ + sel * 512 + h * 128 + ch8;
        u32x4 xr[11];
#pragma unroll
        for (int i = 0; i < 11; ++i) { xr[i] = (u32x4){0u, 0u, 0u, 0u}; if (n > 0 || t0 - 3 + i >= 0) xr[i] = *(const u32x4*)(src + (size_t)i * NPROJ); }
        bf16_t* dst = (bf16_t*)(hl + sel * 18432) + t0 * 144 + ch8;
#pragma unroll
        for (int j = 0; j < 8; ++j) {
            float o[8];
#pragma unroll
            for (int e = 0; e < 8; ++e) {
                float a = 0.f;
#pragma unroll
                for (int k = 0; k < 4; ++k) { const unsigned w = xr[j + k][e >> 1]; a += wv[k][e >> 2][e & 3] * ((e & 1) ? bfhi(w) : bflo(w)); }
                o[e] = silu_(a);
            }
            u32x4 w; w.x = pack2(o[0], o[1]); w.y = pack2(o[2], o[3]); w.z = pack2(o[4], o[5]); w.w = pack2(o[6], o[7]);
            *(u32x4*)(dst + j * 144) = w;
        }
    }
    if (w4 == 3) {
        const int t = lane; const float* gp = gates + (size_t)(row0 + t) * 16;
        const float beta = sigmoid_(gp[12 + h]), g = -__expf(p.gd_a_log[l * 4 + h]) * softplus_(gp[8 + h] + p.gd_dt_bias[l * 4 + h]);
        const float gc = wave_incl_sum(g, lane), gl = __builtin_bit_cast(float, __builtin_amdgcn_readlane(__builtin_bit_cast(int, gc), 63));
        BETA[t] = beta; GC[t] = gc; EGC[t] = __expf(gc); EKD[t] = __expf(gl - gc);
    }
    __syncthreads();
#pragma unroll
    for (int s2 = 0; s2 < 2; ++s2) {
        const int t = t8 >> 2, part = t8 & 3; bf16_t* xr = (bf16_t*)(hl + s2 * 18432) + t * 144 + part * 32; u32x4 v[4]; float ss = 0.f;
#pragma unroll
        for (int i = 0; i < 4; ++i) { v[i] = *(const u32x4*)(xr + i * 8);
#pragma unroll
            for (int k = 0; k < 4; ++k) { const float a = bflo(v[i][k]), c = bfhi(v[i][k]); ss += a * a + c * c; } }
        ss = sum4_dpp(ss);
        float rn = rsqrtf(ss + EPS); if (s2 == 0) rn *= QSCALE;
        if (part == 0) RN[s2 * 64 + t] = rn;
#pragma unroll
        for (int i = 0; i < 4; ++i) { u32x4 w;
#pragma unroll
            for (int k = 0; k < 4; ++k) w[k] = pack2(bflo(v[i][k]) * rn, bfhi(v[i][k]) * rn);
            *(u32x4*)(xr + i * 8) = w; }
    }
    __syncthreads();
#pragma unroll
    for (int jj = 0; jj < 8; ++jj) {
        const int idx = w4 * 8 + jj, which = idx >> 4, tt = (idx >> 2) & 3, st = idx & 3;
        if (which == 0 && st > tt) continue;
        f32x4 acc = {0.f, 0.f, 0.f, 0.f};
        if (st <= tt) {
            const bf16_t* Ab = which ? Q16 : K16;
#pragma unroll
            for (int ks = 0; ks < 4; ++ks) acc = mfma16(*(const bf16x8*)(Ab + (tt * 16 + r) * 144 + ks * 32 + q * 8), *(const bf16x8*)(K16 + (st * 16 + r) * 144 + ks * 32 + q * 8), acc);
        }
        const int s = st * 16 + r; const float gcs = GC[s];
        bf16_t* aq = (bf16_t*)(rec + 49152);
#pragma unroll
        for (int j = 0; j < 4; ++j) {
            const int t = tt * 16 + q * 4 + j;
            if (which == 0) { const float mv = s < t ? BETA[t] * acc[j] * __expf(GC[t] - gcs) : 0.f; if (st == tt) MMD[(tt * 16 + q * 4 + j) * 16 + r] = mv; MP16[t * 80 + (st >> 1) * 32 + permpos(s & 31)] = f2bf(mv); }
            else aq[t * 64 + (st >> 1) * 32 + permpos(s & 31)] = f2bf(s <= t ? acc[j] * __expf(GC[t] - gcs) : 0.f);
        }
    }
    __syncthreads();
    if (t8 < 64) {
        const int bi = t8 >> 4, c = t8 & 15; float x[16];
#pragma unroll
        for (int t = 0; t < 16; ++t) x[t] = (t == c) ? 1.f : 0.f;
#pragma unroll
        for (int t = 1; t < 16; ++t) { float a = x[t];
#pragma unroll
            for (int s2 = 0; s2 < t; ++s2) a -= MMD[(bi * 16 + t) * 16 + s2] * x[s2];
            x[t] = a; }
#pragma unroll
        for (int t = 0; t < 16; ++t) TP16[(bi * 16 + t) * 48 + ((c >> 2) & 3) * 8 + (c & 3)] = f2bf(x[t]);
    }
#pragma unroll
    for (int k2 = 0; k2 < 2; ++k2) {
        const int task = t8 + 256 * k2, t = task >> 3, grp = task & 7; const bf16_t* xr = Q16 + t * 144 + grp * 16; const float sc = EGC[t];
        const u32x4 a0 = *(const u32x4*)xr, a1 = *(const u32x4*)(xr + 8);
        bf16_t* qd = (bf16_t*)(rec + 16384) + t * 128 + (grp >> 1) * 32;
#pragma unroll
        for (int rr = 0; rr < 4; ++rr) { const unsigned w0 = rr < 2 ? a0[(rr & 1) * 2] : a1[(rr & 1) * 2], w1 = rr < 2 ? a0[(rr & 1) * 2 + 1] : a1[(rr & 1) * 2 + 1];
            u32x2 w; w.x = pack2(bflo(w0) * sc, bfhi(w0) * sc); w.y = pack2(bflo(w1) * sc, bfhi(w1) * sc);
            *(u32x2*)(qd + (rr * 2 + (grp & 1)) * 4) = w; }
    }
    if (t8 >= 128) {
        const int d = t8 - 128; bf16_t* kd = (bf16_t*)(rec + 32768) + d * 64;
#pragma unroll
        for (int p4 = 0; p4 < 16; ++p4) {
            const int pp = (p4 * 4) & 31, s0 = ((p4 * 4) >> 5) * 32 + ((pp >> 2) & 1) * 16 + (pp >> 3) * 4;
            float kv[4];
#pragma unroll
            for (int i = 0; i < 4; ++i) kv[i] = bf2f(K16[(s0 + i) * 144 + d]) * EKD[s0 + i];
            u32x2 w; w.x = pack2(kv[0], kv[1]); w.y = pack2(kv[2], kv[3]);
            *(u32x2*)(kd + p4 * 4) = w;
        }
    }
    if (t8 == 255) *(float*)(rec + 73728) = GC[63];
    __syncthreads();
#pragma unroll
    for (int ci = 0; ci < 4; ++ci) {
        const int ct = w4 * 4 + ci, c = ct * 16 + r;
        f32x4 X[4];
#pragma unroll
        for (int bi = 0; bi < 4; ++bi) {
            f32x4 z = {0.f, 0.f, 0.f, 0.f};
#pragma unroll
            for (int kk = 0; kk < 2; ++kk) {
                if (2 * kk < bi) {
                    const f32x4 zero = {0.f, 0.f, 0.f, 0.f};
                    const bf16x8 Bop = pack_b(X[2 * kk], (2 * kk + 1 < bi) ? X[2 * kk + 1] : zero);
                    z = mfma16(*(const bf16x8*)(MP16 + (bi * 16 + r) * 80 + kk * 32 + q * 8), Bop, z);
                }
            }
#pragma unroll
            for (int j = 0; j < 4; ++j) { const int t = bi * 16 + q * 4 + j;
                const float rv = ct < 8 ? bf2f(V16[t * 144 + c]) * BETA[t] : bf2f(K16[t * 144 + (c - 128)]) * BETA[t] * EGC[t];
                z[j] = rv - z[j]; }
            const f32x4 zero = {0.f, 0.f, 0.f, 0.f};
            X[bi] = mfma16(*(const bf16x8*)(TP16 + (bi * 16 + r) * 48 + q * 8), pack_b(z, zero), zero);
        }
        if (ct < 8) { bf16_t* up = (bf16_t*)(rec + 57344);
#pragma unroll
            for (int bi = 0; bi < 4; ++bi) { u32x2 w; w.x = pack2(X[bi][0], X[bi][1]); w.y = pack2(X[bi][2], X[bi][3]); *(u32x2*)(up + ((ct * 4 + bi) * 64 + lane) * 4) = w; }
        } else { bf16_t* wp = (bf16_t*)rec; const int d = c - 128, pd = (d & ~31) + permpos(d & 31);
#pragma unroll
            for (int bi = 0; bi < 4; ++bi)
#pragma unroll
                for (int j = 0; j < 4; ++j) wp[(bi * 16 + q * 4 + j) * 128 + pd] = f2bf(X[bi][j]); }
    }
    __syncthreads();
}

__device__ __forceinline__ void gd_m2(unsigned char* lds, const Params& p, int l, int b, int h) {
    const int tid = opaque_tid(), lane = tid & 63, wid = __builtin_amdgcn_readfirstlane(tid >> 6), r = lane & 15, q = lane >> 4;
    bf16_t* OB = (bf16_t*)(lds + 122880);
    float* NWT = (float*)(lds + 122880 + 32768);
    bf16_t* proj = (bf16_t*)(p.ws + WS_PROJ);
    const unsigned char* rec0 = p.ws + WS_GDREC + (size_t)((b * 4 + h) * 32) * GDREC_BYTES;
    const int erow = tid >> 3, eseg = tid & 7;
    unsigned soff[7], doff[7];
#pragma unroll
    for (int i = 0; i < 7; ++i) { const int ci = tid + 512 * i;
        if (i < 2) { soff[i] = ci * 16; doff[i] = (ci >> 4) * 288 + (ci & 15) * 16; }
        else if (i < 4) { const int c2 = ci - 1024; soff[i] = 16384 + c2 * 16; doff[i] = 18432 + (c2 >> 4) * 288 + (c2 & 15) * 16; }
        else if (i < 6) { const int c2 = ci - 2048, rw = c2 >> 3; soff[i] = 32768 + c2 * 16; doff[i] = 36864 + rw * 128 + (((c2 & 7) ^ ((rw >> 1) & 7)) * 16); }
        else { const int c2 = ci - 3072, rw = c2 >> 3; soff[i] = 49152 + c2 * 16; doff[i] = 53248 + rw * 128 + (((c2 & 7) ^ ((rw >> 1) & 7)) * 16); } }
    u32x4 st[7];
#pragma unroll
    for (int i = 0; i < 7; ++i) st[i] = *(const u32x4*)(rec0 + soff[i]);
#pragma unroll
    for (int i = 0; i < 7; ++i) *(u32x4*)(lds + doff[i]) = st[i];
    if (tid < 128) NWT[tid] = p.gd_norm_w[l * 128 + tid];
    f32x4 S[8];
#pragma unroll
    for (int d = 0; d < 8; ++d) S[d] = (f32x4){0.f, 0.f, 0.f, 0.f};
    u32x2 un[4]; float egn;
    {
        const unsigned char* up = rec0 + 57344 + wid * 2048;
#pragma unroll
        for (int tt = 0; tt < 4; ++tt) un[tt] = *(const u32x2*)(up + (unsigned)(lane * 8) + tt * 512);
        egn = *(const float*)(rec0 + 73728);
    }
    __syncthreads();
    if (wid >= 4) __builtin_amdgcn_s_setprio(1);
    for (int n = 0; n <= 32; ++n) {
        const int nn = opaque_s(n);
        const unsigned char* cur = lds + (n & 1) * 61440; unsigned char* nxt = lds + ((n + 1) & 1) * 61440;
        const int swz = (r >> 1) & 7;
        const unsigned char* rec = rec0 + (size_t)nn * GDREC_BYTES;
        const unsigned eo = (unsigned)(erow * NPROJ + eseg * 16) * 2u;
        u32x4 zz[2];
        if (n >= 1) {
            const unsigned char* zb = (const unsigned char*)(proj + (size_t)(b * SEQ + (nn - 1) * 64) * NPROJ + COL_GDZ + h * 128);
            zz[0] = *(const u32x4*)(zb + eo); zz[1] = *(const u32x4*)(zb + eo + 16);
        }
        u32x2 uu[4]; const float eg = __expf(egn);
#pragma unroll
        for (int tt = 0; tt < 4; ++tt) uu[tt] = un[tt];
        if (n + 1 < 32) {
#pragma unroll
            for (int i = 0; i < 7; ++i) st[i] = *(const u32x4*)(rec + GDREC_BYTES + soff[i]);
            const unsigned char* up = rec + GDREC_BYTES + 57344 + wid * 2048;
#pragma unroll
            for (int tt = 0; tt < 4; ++tt) un[tt] = *(const u32x2*)(up + (unsigned)(lane * 8) + tt * 512);
            egn = *(const float*)(rec + GDREC_BYTES + 73728);
        }
        __builtin_amdgcn_sched_barrier(0);
        if (n < 32) {
            f32x4 av[4], o[4];
#pragma unroll
            for (int tt = 0; tt < 4; ++tt) { av[tt] = (f32x4){0.f, 0.f, 0.f, 0.f}; o[tt] = (f32x4){0.f, 0.f, 0.f, 0.f}; }
            bf16x8 F0[8], F1[8];
#define GD_LOAD_A(F, ks) do { _Pragma("unroll") for (int tt = 0; tt < 4; ++tt) { F[tt] = *(const bf16x8*)(cur + (tt * 16 + r) * 288 + ((ks) * 32 + q * 8) * 2); \
                F[4 + tt] = *(const bf16x8*)(cur + 18432 + (tt * 16 + r) * 288 + ((ks) * 32 + q * 8) * 2); } } while (0)
#define GD_MMA_A(F, ks) do { const bf16x8 Sb = pack_b(S[2 * (ks)], S[2 * (ks) + 1]); _Pragma("unroll") for (int tt = 0; tt < 4; ++tt) { av[tt] = mfma16(F[tt], Sb, av[tt]); o[tt] = mfma16(F[4 + tt], Sb, o[tt]); } } while (0)
            GD_LOAD_A(F0, 0); __builtin_amdgcn_sched_barrier(0);
            GD_LOAD_A(F1, 1); __builtin_amdgcn_sched_barrier(0); GD_MMA_A(F0, 0); __builtin_amdgcn_sched_barrier(0);
            GD_LOAD_A(F0, 2); __builtin_amdgcn_sched_barrier(0); GD_MMA_A(F1, 1); __builtin_amdgcn_sched_barrier(0);
            GD_LOAD_A(F1, 3); __builtin_amdgcn_sched_barrier(0); GD_MMA_A(F0, 2); __builtin_amdgcn_sched_barrier(0);
#pragma unroll
            for (int tt = 0; tt < 4; ++tt)
#pragma unroll
                for (int k2 = 0; k2 < 2; ++k2) F0[tt * 2 + k2] = *(const bf16x8*)(cur + 53248 + (tt * 16 + r) * 128 + (((k2 * 4 + q) ^ swz) * 16));
            __builtin_amdgcn_sched_barrier(0); GD_MMA_A(F1, 3); __builtin_amdgcn_sched_barrier(0);
#pragma unroll
            for (int tt = 0; tt < 4; ++tt) { const u32x2 w = uu[tt];
                av[tt][0] = bflo(w.x) - av[tt][0]; av[tt][1] = bfhi(w.x) - av[tt][1]; av[tt][2] = bflo(w.y) - av[tt][2]; av[tt][3] = bfhi(w.y) - av[tt][3]; }
            bf16x8 Vb[2];
#pragma unroll
            for (int k2 = 0; k2 < 2; ++k2) Vb[k2] = pack_b(av[2 * k2], av[2 * k2 + 1]);
#pragma unroll
            for (int d = 0; d < 4; ++d)
#pragma unroll
                for (int k2 = 0; k2 < 2; ++k2) F1[d * 2 + k2] = *(const bf16x8*)(cur + 36864 + (d * 16 + r) * 128 + (((k2 * 4 + q) ^ swz) * 16));
            __builtin_amdgcn_sched_barrier(0);
#pragma unroll
            for (int tt = 0; tt < 4; ++tt)
#pragma unroll
                for (int k2 = 0; k2 < 2; ++k2) o[tt] = mfma16(F0[tt * 2 + k2], Vb[k2], o[tt]);
            __builtin_amdgcn_sched_barrier(0);
#pragma unroll
            for (int d = 0; d < 4; ++d)
#pragma unroll
                for (int k2 = 0; k2 < 2; ++k2) F0[d * 2 + k2] = *(const bf16x8*)(cur + 36864 + ((4 + d) * 16 + r) * 128 + (((k2 * 4 + q) ^ swz) * 16));
            __builtin_amdgcn_sched_barrier(0);
#pragma unroll
            for (int d = 0; d < 4; ++d) { S[d] *= eg;
#pragma unroll
                for (int k2 = 0; k2 < 2; ++k2) S[d] = mfma16(F1[d * 2 + k2], Vb[k2], S[d]); }
            __builtin_amdgcn_sched_barrier(0);
#pragma unroll
            for (int d = 0; d < 4; ++d) { S[4 + d] *= eg;
#pragma unroll
                for (int k2 = 0; k2 < 2; ++k2) S[4 + d] = mfma16(F0[d * 2 + k2], Vb[k2], S[4 + d]); }
#undef GD_LOAD_A
#undef GD_MMA_A
            bf16_t* ob = OB + (n & 1) * 8192;
#pragma unroll
            for (int tt = 0; tt < 4; ++tt)
#pragma unroll
                for (int j = 0; j < 4; ++j) ob[(tt * 16 + q * 4 + j) * 128 + wid * 16 + r] = f2bf(o[tt][j]);
        }
        __builtin_amdgcn_sched_barrier(0);
        if (n >= 1) {
            const bf16_t* ob = OB + ((n - 1) & 1) * 8192 + erow * 128 + eseg * 16;
            u32x4 ov[2]; float ss = 0.f;
#pragma unroll
            for (int i = 0; i < 2; ++i) { ov[i] = *(const u32x4*)(ob + i * 8);
#pragma unroll
                for (int k = 0; k < 4; ++k) { const float a = bflo(ov[i][k]), c = bfhi(ov[i][k]); ss += a * a + c * c; } }
            ss = sum8_dpp(ss);
            const float rs = rsqrtf(ss * (1.0f / 128.0f) + EPS);
            unsigned char* yb = (unsigned char*)(proj + (size_t)(b * SEQ + (nn - 1) * 64) * NPROJ + YOFF + 1024 + h * 128);
#pragma unroll
            for (int i = 0; i < 2; ++i) { u32x4 w;
#pragma unroll
                for (int k = 0; k < 4; ++k) { const int e = eseg * 16 + i * 8 + k * 2;
                    w[k] = pack2(bflo(ov[i][k]) * rs * NWT[e] * silu_(bflo(zz[i][k])), bfhi(ov[i][k]) * rs * NWT[e + 1] * silu_(bfhi(zz[i][k]))); }
                *(u32x4*)(yb + eo + i * 16) = w; }
        }
        __builtin_amdgcn_sched_barrier(0);
        if (n + 1 < 32) {
#pragma unroll
            for (int i = 0; i < 7; ++i) *(u32x4*)(nxt + doff[i]) = st[i];
        }
        __syncthreads();
    }
    __builtin_amdgcn_s_setprio(0);
}

__device__ __forceinline__ void ml_m2(unsigned char* lds, const Params& p, int l, int b, int h) {
    const int tid = opaque_tid(), lane = tid & 63, wid = __builtin_amdgcn_readfirstlane(tid >> 6), r = lane & 15, q = lane >> 4;
    constexpr int BUFB = 18432 + 2048;
    float* NV = (float*)(lds + 2 * BUFB);
    float* NWT = NV + 256;
    bf16_t* OB = (bf16_t*)(lds + 2 * BUFB + 2048);
    float* ET = (float*)(lds + 2 * BUFB + 2048 + 32768);
    bf16_t* proj = (bf16_t*)(p.ws + WS_PROJ);
    const unsigned char* rec0 = p.ws + WS_MLREC + (size_t)((b * 4 + h) * 32) * MLREC_BYTES;
    const int erow = tid >> 3, eseg = tid & 7;
    unsigned qsrc[4], qdst[4];
#pragma unroll
    for (int i = 0; i < 4; ++i) { const int ci = tid + 512 * i, rw = ci >> 5, c8 = ci & 31, grp = c8 >> 3, n4 = c8 & 7, p4 = (n4 & 3) * 2 + (n4 >> 2);
        qsrc[i] = (unsigned)(rw * NPROJ + COL_MLQ + h * 128 + c8 * 4) * 2u; qdst[i] = rw * 288 + (grp * 8 + p4) * 8; }
    const unsigned dco = (unsigned)(h * 128 + (lane < 32 ? COL_MLK + lane * 4 : COL_MLV + (lane - 32) * 4)) * 2u;
    u32x2 sq[4]; u32x4 ssc = {0u, 0u, 0u, 0u};
    u32x2 dCn[8], inn[4];
    {
        const unsigned char* pb = (const unsigned char*)(proj + (size_t)(b * SEQ) * NPROJ);
#pragma unroll
        for (int i = 0; i < 4; ++i) sq[i] = *(const u32x2*)(pb + qsrc[i]);
        if (tid < 84) ssc = *(const u32x4*)(rec0 + 32768 + tid * 16);
#pragma unroll
        for (int d = 0; d < 8; ++d) dCn[d] = *(const u32x2*)(pb + (size_t)(wid * 8 + d) * (NPROJ * 2) + dco);
#pragma unroll
        for (int tt = 0; tt < 4; ++tt) inn[tt] = *(const u32x2*)(rec0 + (unsigned)(((wid * 4 + tt) * 64 + lane) * 8));
#pragma unroll
        for (int i = 0; i < 4; ++i) *(u32x2*)(lds + qdst[i]) = sq[i];
        if (tid < 84) *(u32x4*)(lds + 18432 + tid * 16) = ssc;
        if (tid < 256) NV[tid] = 0.f;
        if (tid < 128) NWT[tid] = p.ml_norm_w[l * 512 + h * 128 + tid];
    }
    f32x4 C[8];
#pragma unroll
    for (int d = 0; d < 8; ++d) C[d] = (f32x4){0.f, 0.f, 0.f, 0.f};
    float mst = 0.f, inv_prev = 0.f;
    __syncthreads();
    if (eseg == 0) { const float* sc0 = (const float*)(lds + 18432); const float mloc = sc0[erow], minter = sc0[64 + erow], mt = fmaxf(minter, mloc);
        *(f32x4*)(ET + erow * 4) = (f32x4){__expf(mloc - mt), __expf(minter - mt) * QSCALE, __expf(-mt), 0.f}; }
    __syncthreads();
    if (wid >= 4) __builtin_amdgcn_s_setprio(1);
    for (int n = 0; n <= 32; ++n) {
        const int nn = opaque_s(n);
        const unsigned char* cur = lds + (n & 1) * BUFB; unsigned char* nxt = lds + ((n + 1) & 1) * BUFB;
        const float* sc = (const float*)(cur + 18432);
        const unsigned char* rec = rec0 + (size_t)nn * MLREC_BYTES;
        const unsigned char* pb = (const unsigned char*)(proj + (size_t)(b * SEQ + nn * 64) * NPROJ);
        const unsigned eo = (unsigned)(erow * NPROJ + eseg * 16) * 2u;
        u32x4 gg[2];
        if (n >= 1) {
            const unsigned char* gb = rec - MLREC_BYTES + 16384 + (erow * 128 + eseg * 16) * 2;
            gg[0] = *(const u32x4*)gb; gg[1] = *(const u32x4*)(gb + 16);
        }
        u32x2 dC[8], inum[4]; float nml = 0.f, nbc = 0.f;
#pragma unroll
        for (int d = 0; d < 8; ++d) dC[d] = dCn[d];
#pragma unroll
        for (int tt = 0; tt < 4; ++tt) inum[tt] = inn[tt];
        if (n + 1 < 32) {
            const unsigned char* pn = pb + (size_t)64 * NPROJ * 2;
#pragma unroll
            for (int i = 0; i < 4; ++i) sq[i] = *(const u32x2*)(pn + qsrc[i]);
            if (tid < 84) ssc = *(const u32x4*)(rec + MLREC_BYTES + 32768 + tid * 16);
            nml = *(const float*)(rec + MLREC_BYTES + 32768 + erow * 4); nbc = *(const float*)(rec + MLREC_BYTES + 32768 + 256 + erow * 4);
#pragma unroll
            for (int d = 0; d < 8; ++d) dCn[d] = *(const u32x2*)(pn + (size_t)(wid * 8 + d) * (NPROJ * 2) + dco);
#pragma unroll
            for (int tt = 0; tt < 4; ++tt) inn[tt] = *(const u32x2*)(rec + MLREC_BYTES + (unsigned)(((wid * 4 + tt) * 64 + lane) * 8));
        }
        float inv_cur = 0.f;
        __builtin_amdgcn_sched_barrier(0);
        if (n < 32) {
            const float g = sc[320], mw = sc[321];
            const float mnew = fmaxf(g + mst, mw), alpha = __expf(g + mst - mnew), bet = __expf(mw - mnew);
            f32x4 aq[4];
#pragma unroll
            for (int tt = 0; tt < 4; ++tt) aq[tt] = (f32x4){0.f, 0.f, 0.f, 0.f};
#pragma unroll
            for (int kh = 0; kh < 2; ++kh) {
                bf16x8 FQ[8];
#pragma unroll
                for (int k2 = 0; k2 < 2; ++k2)
#pragma unroll
                    for (int tt = 0; tt < 4; ++tt) FQ[k2 * 4 + tt] = *(const bf16x8*)(cur + (tt * 16 + r) * 288 + ((kh * 2 + k2) * 32 + q * 8) * 2);
                __builtin_amdgcn_sched_barrier(0);
#pragma unroll
                for (int k2 = 0; k2 < 2; ++k2) {
                    const int ks = kh * 2 + k2; const bf16x8 Cb = pack_b(C[2 * ks], C[2 * ks + 1]);
#pragma unroll
                    for (int tt = 0; tt < 4; ++tt) aq[tt] = mfma16(FQ[k2 * 4 + tt], Cb, aq[tt]);
                }
                __builtin_amdgcn_sched_barrier(0);
            }
            bf16_t* ob = OB + (n & 1) * 8192;
#pragma unroll
            for (int tt = 0; tt < 4; ++tt) { const u32x2 w = inum[tt];
#pragma unroll
                for (int j = 0; j < 4; ++j) {
                    const int t = tt * 16 + q * 4 + j;
                    const f32x2v et = *(const f32x2v*)(ET + ((n & 1) * 64 + t) * 4); const float e1 = et.x, e2 = et.y;
                    const unsigned ww = j < 2 ? w.x : w.y; const float iv = (j & 1) ? bfhi(ww) : bflo(ww);
                    ob[t * 128 + wid * 16 + r] = f2bf(e1 * iv + e2 * aq[tt][j]);
                } }
            {
                const float* nv = NV + (n & 1) * 128 + eseg * 16;
                const u32x4 q0 = *(const u32x4*)(cur + erow * 288 + eseg * 32), q1 = *(const u32x4*)(cur + erow * 288 + eseg * 32 + 16);
                float sdot = 0.f;
#pragma unroll
                for (int k = 0; k < 4; ++k) { sdot += bflo(q0[k]) * nv[2 * k] + bfhi(q0[k]) * nv[2 * k + 1]; sdot += bflo(q1[k]) * nv[8 + 2 * k] + bfhi(q1[k]) * nv[8 + 2 * k + 1]; }
                sdot = sum8_dpp(sdot);
                const f32x4 et = *(const f32x4*)(ET + ((n & 1) * 64 + erow) * 4);
                const float den = et[0] * sc[128 + erow] + et[1] * sdot;
                inv_cur = 1.0f / fmaxf(fabsf(den), et[2]);
                if (eseg == 0 && n + 1 < 32) {
                    const float minter = nbc + mnew, mt = fmaxf(minter, nml);
                    *(f32x4*)(ET + (((n + 1) & 1) * 64 + erow) * 4) = (f32x4){__expf(nml - mt), __expf(minter - mt) * QSCALE, __expf(-mt), 0.f};
                }
            }
#pragma unroll
            for (int d = 0; d < 8; ++d) { const u32x2 w = dC[d];
                C[d][0] = alpha * C[d][0] + bet * bflo(w.x); C[d][1] = alpha * C[d][1] + bet * bfhi(w.x);
                C[d][2] = alpha * C[d][2] + bet * bflo(w.y); C[d][3] = alpha * C[d][3] + bet * bfhi(w.y); }
            if (tid < 128) { const int pos = (tid & ~31) + permpos(tid & 31); NV[((n + 1) & 1) * 128 + pos] = alpha * NV[(n & 1) * 128 + pos] + bet * sc[192 + tid]; }
            mst = mnew;
        }
        __builtin_amdgcn_sched_barrier(0);
        if (n >= 1) {
            const bf16_t* ob = OB + ((n - 1) & 1) * 8192 + erow * 128 + eseg * 16;
            u32x4 ov[2]; float ss = 0.f; float hh[16];
#pragma unroll
            for (int i = 0; i < 2; ++i) { ov[i] = *(const u32x4*)(ob + i * 8);
#pragma unroll
                for (int k = 0; k < 4; ++k) { const float a = bflo(ov[i][k]) * inv_prev, c = bfhi(ov[i][k]) * inv_prev; hh[i * 8 + 2 * k] = a; hh[i * 8 + 2 * k + 1] = c; ss += a * a + c * c; } }
            ss = sum8_dpp(ss);
            const float rs = rsqrtf(ss * (1.0f / 128.0f) + EPS);
            unsigned char* yb = (unsigned char*)(proj + (size_t)(b * SEQ + (nn - 1) * 64) * NPROJ + YOFF + 512 + h * 128);
#pragma unroll
            for (int i = 0; i < 2; ++i) { u32x4 w;
#pragma unroll
                for (int k = 0; k < 4; ++k) { const int e = eseg * 16 + i * 8 + k * 2;
                    w[k] = pack2(hh[i * 8 + 2 * k] * rs * NWT[e] * bflo(gg[i][k]), hh[i * 8 + 2 * k + 1] * rs * NWT[e + 1] * bfhi(gg[i][k])); }
                *(u32x4*)(yb + eo + i * 16) = w; }
        }
        inv_prev = inv_cur;
        __builtin_amdgcn_sched_barrier(0);
        if (n + 1 < 32) {
#pragma unroll
            for (int i = 0; i < 4; ++i) *(u32x2*)(nxt + qdst[i]) = sq[i];
            if (tid < 84) *(u32x4*)(nxt + 18432 + tid * 16) = ssc;
        }
        __syncthreads();
    }
    __builtin_amdgcn_s_setprio(0);
}

#define XB_TMO      128
#define XB_XCNT(j)  (256  + 64 * (j))
#define XB_XSUB(j)  (1280 + 64 * (j))
#define XB_XGEN(j)  (2304 + 64 * (j))
#define XB_TOP      3328
#define XB_TOPGEN   3392
#define XCD_BAR_WORDS 3456
#define XB_SPIN_CAP (1u << 18)

__device__ __forceinline__ unsigned xb_ld(unsigned* p)              { return __hip_atomic_load(p, __ATOMIC_RELAXED, __HIP_MEMORY_SCOPE_AGENT); }
__device__ __forceinline__ unsigned xb_add(unsigned* p, unsigned v) { return __hip_atomic_fetch_add(p, v, __ATOMIC_RELAXED, __HIP_MEMORY_SCOPE_AGENT); }
__device__ __forceinline__ unsigned xb_xcc_id() { return (unsigned)__builtin_amdgcn_s_getreg((3 << 11) | 20) & 0xFu; }
#define XB_SPIN(cond, bar) do { unsigned _sp = 0; while (cond) { __builtin_amdgcn_s_sleep(1); \
    if ((++_sp & 255u) == 0u) { if (xb_ld(&(bar)[XB_TMO])) break; if (_sp > XB_SPIN_CAP) { atomicAdd(&(bar)[XB_TMO], 1u); break; } } } } while (0)

struct XcdBarrier {
    unsigned* bar; unsigned x;
    volatile LAS unsigned* st;
};

__device__ __forceinline__ XcdBarrier xcd_barrier_post(unsigned* bar, volatile LAS unsigned* st) {
    XcdBarrier b; b.bar = bar; b.x = xb_xcc_id(); b.st = st;
    if (threadIdx.x == 0) (void)xb_add(&bar[XB_XCNT(b.x)], 1u);
    return b;
}
__device__ __forceinline__ void xcd_barrier_complete(unsigned* bar, unsigned x, unsigned& nloc, unsigned& nx) {
    const unsigned G = gridDim.x * gridDim.y * gridDim.z;
    unsigned sum, cnt, mine, sp = 0u;
    for (;;) {
        sum = 0u; cnt = 0u; mine = 0u;
#pragma unroll
        for (unsigned j = 0; j < 16; ++j) { const unsigned c = xb_ld(&bar[XB_XCNT(j)]); sum += c; cnt += (c > 0u) ? 1u : 0u; mine = (j == x) ? c : mine; }
        if (sum == G) break;
        __builtin_amdgcn_s_sleep(1);
        if ((++sp & 255u) == 0u) { if (xb_ld(&bar[XB_TMO])) break; if (sp > XB_SPIN_CAP) { atomicAdd(&bar[XB_TMO], 1u); break; } }
    }
    nloc = mine > 0u ? mine : 1u; nx = cnt > 0u ? cnt : 1u;
}

__device__ __forceinline__ void xcd_barrier(const XcdBarrier& b) {
    asm volatile("s_waitcnt vmcnt(0)" ::: "memory");
    __syncthreads();
    if (threadIdx.x == 0) {
        unsigned* bar = b.bar;
        __builtin_amdgcn_s_waitcnt(0);
        unsigned nloc = b.st[0], nx = b.st[1];
        if (nloc == 0u) { xcd_barrier_complete(bar, b.x, nloc, nx); b.st[0] = nloc; b.st[1] = nx; }
        const unsigned old = xb_add(&bar[XB_XSUB(b.x)], 1u);
        const unsigned gen = old / nloc;
        if (old + 1u == (gen + 1u) * nloc) {
            __builtin_amdgcn_fence(__ATOMIC_RELEASE, "agent");
            asm volatile("s_waitcnt vmcnt(0)" ::: "memory");
            const unsigned og = xb_add(&bar[XB_TOP], 1u);
            const unsigned tg = og / nx;
            if (og + 1u == (tg + 1u) * nx) xb_add(&bar[XB_TOPGEN], 1u);
            else XB_SPIN(xb_ld(&bar[XB_TOPGEN]) == tg, bar);
            __builtin_amdgcn_fence(__ATOMIC_ACQUIRE, "agent");
            xb_add(&bar[XB_XGEN(b.x)], 1u);
            asm volatile("s_waitcnt vmcnt(0)" ::: "memory");
        } else {
            XB_SPIN(xb_ld(&bar[XB_XGEN(b.x)]) == gen, bar);
            __builtin_amdgcn_fence(__ATOMIC_ACQUIRE, "agent");
            asm volatile("s_waitcnt vmcnt(0)" ::: "memory");
        }
    }
    __syncthreads();
}


#ifndef N_LAUNCH_MODE
#define N_LAUNCH_MODE 1
#endif
#ifndef PROBE_REPEAT
#define PROBE_REPEAT -1
#endif
#ifndef PROBE_SUB
#define PROBE_SUB 0
#endif
#define REP(k) ((k) == PROBE_REPEAT ? 2 : 1)
__global__ void __launch_bounds__(512, 2) hymba_mega(Params p, int ph_lo, int ph_hi) {
    extern __shared__ __attribute__((aligned(16))) unsigned char lds[];
    cg::grid_group grid = cg::this_grid();
    const int G = gridDim.x, bid = blockIdx.x;
    volatile LAS unsigned* xst = (volatile LAS unsigned*)((LAS unsigned char*)lds + (LDS_BYTES - 16));
    if (threadIdx.x < 2) xst[threadIdx.x] = 0u;
    __syncthreads();
    const XcdBarrier xb = xcd_barrier_post((unsigned*)(p.ws + WS_BAR), xst);
    int ph = 0;
#if N_LAUNCH_MODE == 1
#define PHASE_BEGIN {
#define PHASE_END if (ph + 1 < 18) { if (ph == 0) grid.sync(); else xcd_barrier(xb); } } ++ph;
#else
#define PHASE_BEGIN if (ph >= ph_lo && ph < ph_hi) {
#define PHASE_END if (ph + 1 < ph_hi) grid.sync(); } ++ph;
#endif
    PHASE_BEGIN
        for (int rep = 0; rep < REP(0); ++rep) { if (rep) grid.sync();
        for (int u = bid; u < NU_P0; u += G) p0_unit(lds, p, u); }
    PHASE_END
    for (int l = 0; l < DEPTH; ++l) {
        PHASE_BEGIN
            for (int rep = 0; rep < REP(1); ++rep) { if (rep) grid.sync();
            pg8::Gemm g{(const bf16_t*)(p.ws + WS_XB), (const bf16_t*)(p.ws + WS_BTIN), NTOK, NPAD, DM, DM};
            pg8::StaticOrder S; S.init(NTOK, NPAD, G, opaque_s(bid));
            LAS float* rtab = (LAS float*)((LAS unsigned char*)lds + 131072);
            {
                const float* ssq = (const float*)(p.ws + WS_SSQ); pg8::Unit uu;
                for (int i = 0; i < 8 && S.next(i, uu); ++i) {
                    const int tq = opaque_tid(), rl = tq >> 1, hf = tq & 1; const f32x4* sp = (const f32x4*)(ssq + (size_t)(uu.pm * 256 + rl) * 16 + hf * 8);
                    const f32x4 s0 = sp[0], s1 = sp[1]; float ss = ((s0[0] + s0[1]) + (s0[2] + s0[3])) + ((s1[0] + s1[1]) + (s1[2] + s1[3]));
                    ss += __shfl_xor(ss, 1);
                    if (hf == 0) rtab[i * 256 + rl] = rsqrtf(ss * (1.0f / 1024.0f) + EPS);
                }
                __syncthreads();
            }
            EpiIn E{(bf16_t*)(p.ws + WS_PROJ), (float*)(p.ws + WS_GATES), rtab, 0};
            pg8::gemm_phase<EpiIn>((LAS unsigned char*)lds, g, S, E); }
        PHASE_END
        PHASE_BEGIN
            for (int rep = 0; rep < REP(2); ++rep) { if (rep) grid.sync();
            for (int j = bid; j < 512; j += G) { const int u = 2 * j + (opaque_tid() >> 8); gd_m1c(lds, p, l, u >> 7, (u >> 5) & 3, u & 31); }
            for (int j = bid; j < 512; j += G) { const int v = 2 * j + (opaque_tid() >> 8); ml_m1c(lds, p, l, v >> 7, (v >> 5) & 3, v & 31); }
            for (int u = 2048 + bid; u < 2048 + 256; u += G) {
                { const int v = u - 2048; if (rep == 0 || PROBE_SUB == 0 || PROBE_SUB == 2) rg_unit2(lds, p, l, v >> 5, v & 31, 0); }
            } }
        PHASE_END
        PHASE_BEGIN
            for (int rep = 0; rep < REP(3); ++rep) { if (rep) grid.sync();
            for (int u = bid; u < 64; u += G) { if (u < 32) { if (rep == 0 || PROBE_SUB == 0 || PROBE_SUB == 1) gd_m2(lds, p, l, u >> 2, u & 3); }
                else { if (rep == 0 || PROBE_SUB == 0 || PROBE_SUB == 2) ml_m2(lds, p, l, (u - 32) >> 2, (u - 32) & 3); } }
            const int nb2 = G > 64 ? G - 64 : G, b2 = G > 64 ? bid - 64 : bid;
            const int ncv = l + 1 < DEPTH ? NU_BTIN : 0;
            if (b2 >= 0 && (rep == 0 || PROBE_SUB == 0 || PROBE_SUB == 3)) for (int u = b2; u < 256 + ncv; u += nb2) {
                if (u < 256) rg_unit2(lds, p, l, u >> 5, u & 31, 1);
                else cvt_btin_unit(lds, p, l + 1, u - 256);
            } }
        PHASE_END
        PHASE_BEGIN
            for (int rep = 0; rep < (l == 0 ? REP(4) : 1); ++rep) { if (rep) grid.sync();
            pg8::Gemm g{(const bf16_t*)(p.ws + WS_PROJ) + YOFF, (const bf16_t*)(p.ws + WS_BTOUT) + (size_t)l * DM * DMIX, NTOK, DM, DMIX, NPROJ};
            pg8::StaticOrder S; S.init(NTOK, DM, G, opaque_s(bid));
            EpiOut E{p.out, (bf16_t*)(p.ws + WS_XB), (float*)(p.ws + WS_SSQ), l == DEPTH - 1 ? 1 : 0};
            pg8::gemm_phase<EpiOut>((LAS unsigned char*)lds, g, S, E); }
        PHASE_END
    }
    PHASE_BEGIN
        const int tid = opaque_tid(), lane = tid & 63, wid = tid >> 6;
        const float* ssq = (const float*)(p.ws + WS_SSQ);
        for (int row = bid * 8 + wid; row < NTOK; row += G * 8) {
            float s = lane < 16 ? ssq[(size_t)row * 16 + lane] : 0.f; s = wave_sum(s);
            const float rr = rsqrtf(s * (1.0f / 1024.0f) + EPS);
            float* xr = p.out + (size_t)row * DM;
#pragma unroll
            for (int i = 0; i < 4; ++i) { const int c = i * 256 + lane * 4; f32x4 v = *(const f32x4*)(xr + c); const f32x4 w = *(const f32x4*)(p.final_norm_w + c);
                v[0] = v[0] * rr * w[0]; v[1] = v[1] * rr * w[1]; v[2] = v[2] * rr * w[2]; v[3] = v[3] * rr * w[3]; *(f32x4*)(xr + c) = v; }
        }
    PHASE_END
}

extern "C" void kernel_launch(void* const* d_in, const int* in_sizes, int n_in, void* d_out, int out_size, void* d_ws, size_t ws_size, hipStream_t stream) {
    static int grid = 0;
    if (grid == 0) {
        if (ws_size < WS_END) { fprintf(stderr, "kernel_launch: workspace too small (%zu < %zu)\n", ws_size, (size_t)WS_END); grid = -1; return; }
        int dev = 0, cus = 0, per_cu = 0;
        hipGetDevice(&dev);
        hipDeviceGetAttribute(&cus, hipDeviceAttributeMultiprocessorCount, dev);
        hipFuncSetAttribute((const void*)hymba_mega, hipFuncAttributeMaxDynamicSharedMemorySize, LDS_BYTES);
        hipOccupancyMaxActiveBlocksPerMultiprocessor(&per_cu, (const void*)hymba_mega, 512, LDS_BYTES);
        if (per_cu < 1) { fprintf(stderr, "kernel_launch: occupancy query says %d blocks per CU\n", per_cu); per_cu = 1; }
        if (per_cu > 1) per_cu = 1;
        grid = cus * per_cu;
    }
    if (grid < 0) return;
    Params p{};
    p.x = (const float*)d_in[0]; p.norm_w = (const float*)d_in[1]; p.w_in = (const float*)d_in[2]; p.rg_conv_w = (const float*)d_in[3]; p.rg_conv_b = (const float*)d_in[4];
    p.rg_gate_w = (const float*)d_in[5]; p.rg_gate_b = (const float*)d_in[6]; p.rg_lambda = (const float*)d_in[7]; p.ml_gate_b = (const float*)d_in[8]; p.ml_norm_w = (const float*)d_in[9];
    p.gd_conv_w = (const float*)d_in[10]; p.gd_a_log = (const float*)d_in[11]; p.gd_dt_bias = (const float*)d_in[12]; p.gd_norm_w = (const float*)d_in[13]; p.w_out = (const float*)d_in[14];
    p.final_norm_w = (const float*)d_in[15]; p.out = (float*)d_out; p.ws = (unsigned char*)d_ws;
#if N_LAUNCH_MODE == 1
    (void)hipMemsetAsync((char*)d_ws + WS_BAR, 0, WS_BAR_BYTES, stream);
    int lo = 0, hi = 18;
    void* args[] = {&p, &lo, &hi};
    hipError_t e = hipLaunchCooperativeKernel((const void*)hymba_mega, dim3(grid), dim3(512), args, LDS_BYTES, stream);
    if (e != hipSuccess) fprintf(stderr, "cooperative launch failed: %s (grid %d)\n", hipGetErrorString(e), grid);
#else
    for (int ph = 0; ph < 18; ++ph) hipLaunchKernelGGL(hymba_mega, dim3(grid), dim3(512), LDS_BYTES, stream, p, ph, ph + 1);
#endif
}
```

```cpp
#include <hip/hip_runtime.h>
#include <hip/hip_cooperative_groups.h>
#include <cstdio>
namespace cg = cooperative_groups;

#define LAS __attribute__((address_space(3)))
typedef unsigned short bf16_t;
typedef short bf16x8 __attribute__((ext_vector_type(8)));
typedef float f32x4 __attribute__((ext_vector_type(4)));
typedef unsigned u32x4 __attribute__((ext_vector_type(4)));
typedef unsigned u32x2 __attribute__((ext_vector_type(2)));

constexpr int NTOK = 16384, DM = 1024, DIN = 5648, NPROJ = 5632, NPAD = 5888, DMIX = 1536, DEPTH = 4, SEQ = 2048;
constexpr int YOFF = 3584;
constexpr int COL_RGX = 0, COL_RGZ = 512, COL_MLQ = 1024, COL_MLK = 1536, COL_MLV = 2048, COL_MLO = 2560, COL_MLZ = 3072, COL_GDQ = 3584, COL_GDZ = 5120;
constexpr float QSCALE = 0.08838834764831845f;
constexpr float EPS = 1e-6f;
constexpr int LDS_BYTES = 159744;

constexpr size_t WS_BTIN = 0;
constexpr size_t WS_BTOUT = WS_BTIN + (size_t)NPAD * DM * 2;
constexpr size_t WS_WT16 = WS_BTOUT + (size_t)DEPTH * DM * DMIX * 2;
constexpr size_t WS_XB = WS_WT16 + (size_t)DEPTH * 2 * 8 * 64 * 64 * 2;
constexpr size_t WS_SSQ = WS_XB + (size_t)NTOK * DM * 2;
constexpr size_t WS_GATES = WS_SSQ + (size_t)NTOK * 16 * 4;
constexpr size_t WS_RGSUM = WS_GATES + (size_t)NTOK * 16 * 4;
constexpr size_t WS_PROJ = WS_RGSUM + (size_t)8 * 32 * 512 * 2 * 4;
constexpr size_t WS_MLREC = WS_PROJ + (size_t)NTOK * NPROJ * 2;
constexpr int MLREC_BYTES = 16384 + 16384 + 2048;
constexpr size_t WS_GDREC = WS_MLREC + (size_t)1024 * MLREC_BYTES;
constexpr int GDREC_BYTES = 73984;
constexpr size_t WS_BAR = WS_GDREC + (size_t)1024 * GDREC_BYTES;
constexpr size_t WS_BAR_BYTES = 16384;
constexpr size_t WS_END = WS_BAR + WS_BAR_BYTES;

struct Params {
    const float* x; const float* norm_w; const float* w_in; const float* rg_conv_w; const float* rg_conv_b; const float* rg_gate_w; const float* rg_gate_b;
    const float* rg_lambda; const float* ml_gate_b; const float* ml_norm_w; const float* gd_conv_w; const float* gd_a_log; const float* gd_dt_bias;
    const float* gd_norm_w; const float* w_out; const float* final_norm_w;
    float* out; unsigned char* ws;
};

__device__ __forceinline__ int opaque_s(int v) { asm volatile("" : "+s"(v)); return v; }
__device__ __forceinline__ int opaque_tid() { int t = threadIdx.x; asm volatile("" : "+v"(t)); return t; }
typedef __bf16 hbf16x2 __attribute__((ext_vector_type(2)));
typedef float f32x2v __attribute__((ext_vector_type(2)));
__device__ __forceinline__ bf16_t f2bf(float f) { const __bf16 h = (__bf16)f; return __builtin_bit_cast(bf16_t, h); }
__device__ __forceinline__ float bf2f(bf16_t b) { return __uint_as_float(((unsigned)b) << 16); }
__device__ __forceinline__ unsigned pack2(float lo, float hi) { const f32x2v v = {lo, hi}; return __builtin_bit_cast(unsigned, __builtin_convertvector(v, hbf16x2)); }
__device__ __forceinline__ float bflo(unsigned w) { return __uint_as_float(w << 16); }
__device__ __forceinline__ float bfhi(unsigned w) { return __uint_as_float(w & 0xFFFF0000u); }
__device__ __forceinline__ float sigmoid_(float x) { return __builtin_amdgcn_rcpf(1.f + __expf(-x)); }
__device__ __forceinline__ float silu_(float x) { return x * __builtin_amdgcn_rcpf(1.f + __expf(-x)); }
__device__ __forceinline__ float neg_expm1_(float x) { const float ps = -x * (1.f + x * (0.5f + x * (0.16666667f + x * (0.041666668f + x * (0.0083333338f + x * 0.0013888889f))))); return x > -0.25f ? ps : 1.f - __expf(x); }
__device__ __forceinline__ float softplus_(float x) { return fmaxf(x, 0.f) + log1pf(__expf(-fabsf(x))); }
__device__ __forceinline__ float sum8_dpp(float v) {
    v += __builtin_bit_cast(float, __builtin_amdgcn_mov_dpp(__builtin_bit_cast(int, v), 0xB1, 0xF, 0xF, true));
    v += __builtin_bit_cast(float, __builtin_amdgcn_mov_dpp(__builtin_bit_cast(int, v), 0x4E, 0xF, 0xF, true));
    v += __builtin_bit_cast(float, __builtin_amdgcn_mov_dpp(__builtin_bit_cast(int, v), 0x141, 0xF, 0xF, true));
    return v;
}
__device__ __forceinline__ float sum16_dpp(float v) {
    v = sum8_dpp(v);
    v += __builtin_bit_cast(float, __builtin_amdgcn_mov_dpp(__builtin_bit_cast(int, v), 0x140, 0xF, 0xF, true));
    return v;
}
__device__ __forceinline__ float sum4_dpp(float v) {
    v += __builtin_bit_cast(float, __builtin_amdgcn_mov_dpp(__builtin_bit_cast(int, v), 0xB1, 0xF, 0xF, true));
    v += __builtin_bit_cast(float, __builtin_amdgcn_mov_dpp(__builtin_bit_cast(int, v), 0x4E, 0xF, 0xF, true));
    return v;
}
__device__ __forceinline__ float wave_sum(float v) { for (int o = 32; o; o >>= 1) v += __shfl_xor(v, o); return v; }
#define DPP_F(old, v, ctrl, rm, bc) __builtin_bit_cast(float, __builtin_amdgcn_update_dpp(__builtin_bit_cast(int, (float)(old)), __builtin_bit_cast(int, (float)(v)), ctrl, rm, 0xF, bc))
__device__ __forceinline__ float wave_incl_sum(float v, int) {
    v += DPP_F(0.f, v, 0x111, 0xF, true); v += DPP_F(0.f, v, 0x112, 0xF, true); v += DPP_F(0.f, v, 0x114, 0xF, true); v += DPP_F(0.f, v, 0x118, 0xF, true);
    v += DPP_F(0.f, v, 0x142, 0xA, false); v += DPP_F(0.f, v, 0x143, 0xC, false);
    return v;
}
__device__ __forceinline__ float wave_incl_max(float v, int) {
    const float ninf = -__builtin_inff();
    v = fmaxf(v, DPP_F(ninf, v, 0x111, 0xF, false)); v = fmaxf(v, DPP_F(ninf, v, 0x112, 0xF, false)); v = fmaxf(v, DPP_F(ninf, v, 0x114, 0xF, false)); v = fmaxf(v, DPP_F(ninf, v, 0x118, 0xF, false));
    v = fmaxf(v, DPP_F(ninf, v, 0x142, 0xA, false)); v = fmaxf(v, DPP_F(ninf, v, 0x143, 0xC, false));
    return v;
}
__device__ __forceinline__ float wave_max(float v) { return __builtin_bit_cast(float, __builtin_amdgcn_readlane(__builtin_bit_cast(int, wave_incl_max(v, 0)), 63)); }
__device__ __forceinline__ f32x4 mfma16(bf16x8 a, bf16x8 b, f32x4 c) { return __builtin_amdgcn_mfma_f32_16x16x32_bf16(a, b, c, 0, 0, 0); }
__device__ __forceinline__ bf16x8 pack_b(const f32x4& t0, const f32x4& t1) {
    u32x4 w; w.x = pack2(t0[0], t0[1]); w.y = pack2(t0[2], t0[3]); w.z = pack2(t1[0], t1[1]); w.w = pack2(t1[2], t1[3]);
    return __builtin_bit_cast(bf16x8, w);
}
__device__ __forceinline__ int permpos(int nat) { return ((nat >> 2) & 3) * 8 + (nat >> 4) * 4 + (nat & 3); }

namespace pg8 {
constexpr int BM = 256, BK = 64, HALF = 128, HTB = HALF * BK * 2, NXCD = 8, WGM = 8;
__device__ __forceinline__ int lds_byte(int r, int c) { const int st = (r >> 4) * 2 + (c >> 5), rr = r & 15, cc = c & 31, ob = rr * 64 + cc * 2; return st * 1024 + (ob ^ (((ob >> 9) & 1) << 5)); }
__device__ __forceinline__ void stage_rc(int b, int& R, int& C) { const int st = b / 1024, sb = b % 1024, swz = sb ^ (((sb >> 9) & 1) << 5); R = (st >> 1) * 16 + swz / 64; C = (st & 1) * 32 + (swz % 64) / 2; }
__device__ __forceinline__ int perm32(int rho) { const int n = rho >> 4, i = rho & 15; return 8 * (i >> 2) + 4 * n + (i & 3); }
struct Unit { int pm, pn; };
struct Gemm { const bf16_t* A; const bf16_t* Bt; int M, N, K, lda; };
struct StaticOrder {
    int nM, nN, nwg, G, c;
    __device__ __forceinline__ void init(int M, int N, int G_, int c_) { nM = M / BM; nN = N / BM; nwg = nM * nN; G = G_; c = c_; }
    __device__ __forceinline__ bool next(int i, Unit& u) const {
        const long L = (long)i * G + c; if (L >= nwg) return false;
        int wgid = (int)L; { const int q = nwg / NXCD, r = nwg % NXCD, xcd = wgid % NXCD, off = wgid / NXCD; wgid = (xcd < r ? xcd * (q + 1) : r * (q + 1) + (xcd - r) * q) + off; }
        const int nig = WGM * nN, gid = wgid / nig, fm = gid * WGM, gsz = (nM - fm) < WGM ? (nM - fm) : WGM;
        u.pm = __builtin_amdgcn_readfirstlane(fm + ((wgid % nig) % gsz)); u.pn = __builtin_amdgcn_readfirstlane((wgid % nig) / gsz); return true;
    }
};
template <class Epi>
__device__ __forceinline__ void gemm_phase(LAS unsigned char* lds, const Gemm g, const StaticOrder& S, const Epi& E) {
    const int tid = opaque_tid(), wid = __builtin_amdgcn_readfirstlane(tid >> 6), lane = tid & 63, wr = wid >> 2, wc = wid & 3, fr = lane & 15, fq = lane >> 4;
    const int K = g.K, nt = K / BK, lda = g.lda;
    unsigned voffA[2], voffB[2];
#pragma unroll
    for (int i = 0; i < 2; ++i) { int R, C; stage_rc(tid * 16 + i * 8192, R, C); const int Rb = (R & ~31) + perm32(R & 31);
        voffA[i] = (unsigned)(R * lda + C) * 2u; voffB[i] = (unsigned)(Rb * K + C) * 2u; }
    const size_t kstep = (size_t)(BK * 2);
    const size_t hstepA = (size_t)HALF * lda * 2, hstepB = (size_t)HALF * K * 2;
    const size_t tstepA = 2 * hstepA, tstepB = 2 * hstepB;
    const unsigned ldsw = (unsigned)wid * 1024u;
    const int aoff = lds_byte(wr * 64 + fr, fq * 8), boff = lds_byte(wc * 32 + fr, fq * 8);
#define PG8_SA(b, h) (((b) * 2 + (h)) * HTB)
#define PG8_SB(b, h) ((4 + (b) * 2 + (h)) * HTB)
#define PG8_STAGE(bufoff, gbase, voff) do { _Pragma("unroll") for (int _i = 0; _i < 2; ++_i) \
        __builtin_amdgcn_global_load_lds((const unsigned*)((const char*)(gbase) + (voff)[_i]), (LAS unsigned*)(lds + (bufoff) + ldsw + _i * 8192), 16, 0, 0); } while (0)
#define PG8_LDA(dst, b, h) do { _Pragma("unroll") for (int m = 0; m < 4; ++m) _Pragma("unroll") for (int k = 0; k < 2; ++k) dst[m][k] = *(const LAS bf16x8*)(lds + PG8_SA(b, h) + aoff + m * 2048 + k * 1024); } while (0)
#define PG8_LDB(dst, b, h) do { _Pragma("unroll") for (int n = 0; n < 2; ++n) _Pragma("unroll") for (int k = 0; k < 2; ++k) dst[n][k] = *(const LAS bf16x8*)(lds + PG8_SB(b, h) + boff + n * 2048 + k * 1024); } while (0)
#define PG8_MMA(ai, bj, At, Bt) do { __builtin_amdgcn_s_setprio(1); _Pragma("unroll") for (int m = 0; m < 4; ++m) _Pragma("unroll") for (int n = 0; n < 2; ++n) _Pragma("unroll") for (int k = 0; k < 2; ++k) \
        acc[ai][bj][m][n] = __builtin_amdgcn_mfma_f32_16x16x32_bf16(Bt[n][k], At[m][k], acc[ai][bj][m][n], 0, 0, 0); __builtin_amdgcn_s_setprio(0); } while (0)
#define PG8_WAIT_V(n) asm volatile("s_waitcnt vmcnt(" #n ")" ::: "memory")
#define PG8_WAIT_L(n) asm volatile("s_waitcnt lgkmcnt(" #n ")" ::: "memory")
#define PG8_BAR __builtin_amdgcn_s_barrier()
#define PG8_SCHED __builtin_amdgcn_sched_barrier(0)
    Unit cur, nxt; int ui = 0;
    if (!S.next(0, cur)) return;
    f32x4 acc[2][2][4][2];
#pragma unroll
    for (int a = 0; a < 2; ++a)
#pragma unroll
        for (int b = 0; b < 2; ++b)
#pragma unroll
            for (int m = 0; m < 4; ++m)
#pragma unroll
                for (int n = 0; n < 2; ++n) acc[a][b][m][n] = (f32x4){0.f, 0.f, 0.f, 0.f};
    bf16x8 At[4][2], B0[2][2], B1[2][2];
    const char* cA = (const char*)g.A + (size_t)cur.pm * tstepA; const char* cB = (const char*)g.Bt + (size_t)cur.pn * tstepB;
    PG8_STAGE(PG8_SB(0, 0), cB, voffB); PG8_STAGE(PG8_SA(0, 0), cA, voffA); PG8_STAGE(PG8_SB(0, 1), cB + hstepB, voffB); PG8_STAGE(PG8_SA(0, 1), cA + hstepA, voffA);
    if (wr == 1) PG8_BAR;
    PG8_WAIT_V(4); PG8_BAR;
    PG8_STAGE(PG8_SB(1, 0), cB + kstep, voffB); PG8_STAGE(PG8_SA(1, 0), cA + kstep, voffA); PG8_STAGE(PG8_SB(1, 1), cB + hstepB + kstep, voffB);
    PG8_WAIT_V(6); PG8_BAR;
    for (;;) {
        const bool has_next = S.next(ui + 1, nxt);
        const char* nA = has_next ? (const char*)g.A + (size_t)nxt.pm * tstepA : cA; const char* nB = has_next ? (const char*)g.Bt + (size_t)nxt.pn * tstepB : cB;
        for (int t = 0; t < nt; t += 2) {
            const bool last = (t == nt - 2);
            const char* a1 = cA + (size_t)(t + 1) * kstep;
            const char* a2 = last ? nA : cA + (size_t)(t + 2) * kstep; const char* b2 = last ? nB : cB + (size_t)(t + 2) * kstep;
            const char* a3 = a2 + kstep; const char* b3 = b2 + kstep;
            PG8_LDB(B0, 0, 0); PG8_SCHED; PG8_LDA(At, 0, 0); PG8_STAGE(PG8_SA(1, 1), a1 + hstepA, voffA);
            PG8_WAIT_L(8); PG8_BAR; PG8_WAIT_L(0); PG8_MMA(0, 0, At, B0); PG8_BAR; PG8_SCHED;
            PG8_LDB(B1, 0, 1); PG8_STAGE(PG8_SB(0, 0), b2, voffB);
            PG8_BAR; PG8_WAIT_L(0); PG8_MMA(0, 1, At, B1); PG8_BAR;
            PG8_LDA(At, 0, 1); PG8_STAGE(PG8_SA(0, 0), a2, voffA);
            PG8_BAR; PG8_WAIT_L(0); PG8_MMA(1, 0, At, B0); PG8_BAR; PG8_SCHED;
            PG8_STAGE(PG8_SB(0, 1), b2 + hstepB, voffB);
            PG8_WAIT_V(6); PG8_BAR; PG8_MMA(1, 1, At, B1); PG8_BAR;
            PG8_LDB(B0, 1, 0); PG8_SCHED; PG8_LDA(At, 1, 0); PG8_STAGE(PG8_SA(0, 1), a2 + hstepA, voffA);
            PG8_WAIT_L(8); PG8_BAR; PG8_WAIT_L(0); PG8_MMA(0, 0, At, B0); PG8_BAR; PG8_SCHED;
            PG8_LDB(B1, 1, 1); PG8_STAGE(PG8_SB(1, 0), b3, voffB);
            PG8_BAR; PG8_WAIT_L(0); PG8_MMA(0, 1, At, B1); PG8_BAR;
            PG8_LDA(At, 1, 1); PG8_STAGE(PG8_SA(1, 0), a3, voffA);
            PG8_BAR; PG8_WAIT_L(0); PG8_MMA(1, 0, At, B0); PG8_BAR; PG8_SCHED;
            PG8_STAGE(PG8_SB(1, 1), b3 + hstepB, voffB);
            PG8_WAIT_V(6); PG8_BAR; PG8_MMA(1, 1, At, B1); PG8_BAR;
        }
        E(acc, cur, wr, wc, fr, fq, ui);
        if (!has_next) break;
#pragma unroll
        for (int a = 0; a < 2; ++a)
#pragma unroll
            for (int b = 0; b < 2; ++b)
#pragma unroll
                for (int m = 0; m < 4; ++m)
#pragma unroll
                    for (int n = 0; n < 2; ++n) acc[a][b][m][n] = (f32x4){0.f, 0.f, 0.f, 0.f};
        cur = nxt; cA = nA; cB = nB; ++ui;
    }
    PG8_WAIT_V(0);
    if (wr == 0) PG8_BAR;
    PG8_BAR;
#undef PG8_SA
#undef PG8_SB
#undef PG8_STAGE
#undef PG8_LDA
#undef PG8_LDB
#undef PG8_MMA
#undef PG8_WAIT_V
#undef PG8_WAIT_L
#undef PG8_BAR
#undef PG8_SCHED
}
}

struct EpiIn {
    bf16_t* proj; float* gates; const LAS float* rtab; int ui;
    __device__ __forceinline__ void operator()(const f32x4 (&acc)[2][2][4][2], const pg8::Unit& u, int wr, int wc, int fr, int fq, int uidx) const {
        const int row0 = u.pm * 256 + wr * 64 + fr;
        const LAS float* rt = rtab + uidx * 256 + wr * 64 + fr;
#pragma unroll
        for (int ai = 0; ai < 2; ++ai)
#pragma unroll
            for (int m = 0; m < 4; ++m) {
                const int row = row0 + ai * 128 + m * 16;
                const float r = rt[ai * 128 + m * 16];
                if (u.pn < 22) {
#pragma unroll
                    for (int bj = 0; bj < 2; ++bj) {
                        const int col = u.pn * 256 + bj * 128 + wc * 32 + 8 * fq;
                        const f32x4 v0 = acc[ai][bj][m][0] * r, v1 = acc[ai][bj][m][1] * r;
                        u32x4 w; w.x = pack2(v0[0], v0[1]); w.y = pack2(v0[2], v0[3]); w.z = pack2(v1[0], v1[1]); w.w = pack2(v1[2], v1[3]);
                        *(u32x4*)(proj + (size_t)row * NPROJ + col) = w;
                    }
                } else if (wc == 0 && fq < 2) {
                    float* gp = gates + (size_t)row * 16 + 8 * fq;
                    *(f32x4*)gp = acc[ai][0][m][0] * r; *(f32x4*)(gp + 4) = acc[ai][0][m][1] * r;
                }
                __builtin_amdgcn_sched_barrier(0);
            }
    }
};
struct EpiOut {
    float* xout; bf16_t* xb; float* ssq; int last;
    __device__ __forceinline__ void operator()(const f32x4 (&acc)[2][2][4][2], const pg8::Unit& u, int wr, int wc, int fr, int fq, int uidx) const {
        const int row0 = u.pm * 256 + wr * 64 + fr;
#pragma unroll
        for (int ai = 0; ai < 2; ++ai)
#pragma unroll
            for (int m = 0; m < 4; ++m) {
                const int row = row0 + ai * 128 + m * 16; float ss = 0.f;
#pragma unroll
                for (int bj = 0; bj < 2; ++bj) {
                    const int col = u.pn * 256 + bj * 128 + wc * 32 + 8 * fq;
                    const size_t o = (size_t)row * DM + col;
                    const u32x4 xo = *(const u32x4*)(xb + o);
                    f32x4 v0, v1;
                    v0[0] = bflo(xo.x) + acc[ai][bj][m][0][0]; v0[1] = bfhi(xo.x) + acc[ai][bj][m][0][1]; v0[2] = bflo(xo.y) + acc[ai][bj][m][0][2]; v0[3] = bfhi(xo.y) + acc[ai][bj][m][0][3];
                    v1[0] = bflo(xo.z) + acc[ai][bj][m][1][0]; v1[1] = bfhi(xo.z) + acc[ai][bj][m][1][1]; v1[2] = bflo(xo.w) + acc[ai][bj][m][1][2]; v1[3] = bfhi(xo.w) + acc[ai][bj][m][1][3];
                    if (last) { *(f32x4*)(xout + o) = v0; *(f32x4*)(xout + o + 4) = v1; }
                    u32x4 w; w.x = pack2(v0[0], v0[1]); w.y = pack2(v0[2], v0[3]); w.z = pack2(v1[0], v1[1]); w.w = pack2(v1[2], v1[3]);
                    *(u32x4*)(xb + o) = w;
                    ss += (v0[0] * v0[0] + v0[1] * v0[1]) + (v0[2] * v0[2] + v0[3] * v0[3]) + (v1[0] * v1[0] + v1[1] * v1[1]) + (v1[2] * v1[2] + v1[3] * v1[3]);
                }
                ss += __shfl_xor(ss, 16); ss += __shfl_xor(ss, 32);
                if (fq == 0) ssq[(size_t)row * 16 + u.pn * 4 + wc] = ss;
                __builtin_amdgcn_sched_barrier(0);
            }
    }
};

__device__ __forceinline__ int inproj_col(int n) { if (n < 3584) return n; if (n < 5632) return n + 8; const int g = n - 5632; if (g < 8) return 3584 + g; if (g < 16) return 5640 + (g - 8); return -1; }
__device__ __forceinline__ void cvt_tile_W(const float* __restrict__ src, int ld_src, int k0, int n0, bool inmap, const float* __restrict__ kscale, bf16_t* __restrict__ dst, int ld_dst) {
    const int lane = opaque_tid() & 63;
    const int col = inmap ? inproj_col(n0 + lane) : (n0 + lane);
    float v[64];
    const float* sp = src + (size_t)k0 * ld_src + (col >= 0 ? col : 0);
#pragma unroll
    for (int k = 0; k < 64; ++k) v[k] = sp[(size_t)k * ld_src];
    if (kscale) {
#pragma unroll
        for (int k = 0; k < 64; ++k) v[k] *= kscale[k0 + k];
    }
    if (col < 0) {
#pragma unroll
        for (int k = 0; k < 64; ++k) v[k] = 0.f;
    }
    bf16_t* dp = dst + (size_t)(n0 + lane) * ld_dst + k0;
#pragma unroll
    for (int i = 0; i < 8; ++i) { u32x4 w; w.x = pack2(v[i * 8], v[i * 8 + 1]); w.y = pack2(v[i * 8 + 2], v[i * 8 + 3]); w.z = pack2(v[i * 8 + 4], v[i * 8 + 5]); w.w = pack2(v[i * 8 + 6], v[i * 8 + 7]);
        *(u32x4*)(dp + i * 8) = w; }
}
constexpr int NU_BTIN = 92 * 16 / 8;
__device__ __forceinline__ void cvt_btin_unit(unsigned char* lds, const Params& p, int l, int u) {
    const int ti = u * 8 + (opaque_tid() >> 6), nt = ti >> 4, kt = ti & 15;
    cvt_tile_W(p.w_in + (size_t)l * DM * DIN, DIN, kt * 64, nt * 64, true, p.norm_w + l * DM, (bf16_t*)(p.ws + WS_BTIN), DM);
}
constexpr int NU_BTOUT = DEPTH * 24 * 16 / 8, NU_WT = 64 / 8, NU_XROWS = NTOK / 8;
constexpr int NU_P0 = NU_BTIN + NU_BTOUT + NU_WT + NU_XROWS;
__device__ __forceinline__ void p0_unit(unsigned char* lds, const Params& p, int u) {
    if (u < NU_BTIN) { cvt_btin_unit(lds, p, 0, u); return; }
    u -= NU_BTIN;
    if (u < NU_BTOUT) { const int ti = u * 8 + (opaque_tid() >> 6), l = ti / 384, r = ti % 384, kt = r >> 4, nt = r & 15;
        cvt_tile_W(p.w_out + (size_t)l * DMIX * DM, DM, kt * 64, nt * 64, false, nullptr, (bf16_t*)(p.ws + WS_BTOUT) + (size_t)l * DM * DMIX, DMIX); return; }
    u -= NU_BTOUT;
    if (u < NU_WT) { const int ti = u * 8 + (opaque_tid() >> 6); cvt_tile_W(p.rg_gate_w + (size_t)ti * 4096, 64, 0, 0, false, nullptr, (bf16_t*)(p.ws + WS_WT16) + (size_t)ti * 4096, 64); return; }
    u -= NU_WT;
    {
        const int tid = opaque_tid(), lane = tid & 63, wid = tid >> 6, row = u * 8 + wid;
        const float* xr = p.x + (size_t)row * DM; bf16_t* xb = (bf16_t*)(p.ws + WS_XB) + (size_t)row * DM; float ss = 0.f;
#pragma unroll
        for (int i = 0; i < 4; ++i) { const f32x4 v = *(const f32x4*)(xr + i * 256 + lane * 4); ss += (v[0] * v[0] + v[1] * v[1]) + (v[2] * v[2] + v[3] * v[3]);
            u32x2 w; w.x = pack2(v[0], v[1]); w.y = pack2(v[2], v[3]); *(u32x2*)(xb + i * 256 + lane * 4) = w; }
        ss = wave_sum(ss);
        if (lane < 16) ((float*)(p.ws + WS_SSQ))[(size_t)row * 16 + lane] = lane == 0 ? ss : 0.f;
    }
}

__device__ __forceinline__ void rg_unit(unsigned char* lds, const Params& p, int l, int b, int nb, int n, int mode) {
    const int tid = opaque_tid(), lane = tid & 63, wid = tid >> 6, r = lane & 15, q = lane >> 4;
    bf16_t* XC16 = (bf16_t*)lds; bf16_t* WT = (bf16_t*)(lds + 9216); float* XC = (float*)(lds + 27648); float* AA = (float*)(lds + 44288); float* BB = (float*)(lds + 60928);
    float* SEG = (float*)(lds + 77568); float* H0 = (float*)(lds + 81664);
    bf16_t* proj = (bf16_t*)(p.ws + WS_PROJ); float* rgsum = (float*)(p.ws + WS_RGSUM);
    const int t0 = n * 64, row0 = b * SEQ + t0, ch0 = nb * 64;
    float* SUM = (float*)(lds + 81920);
    f32x4 sm4[2] = {{0.f, 0.f, 0.f, 0.f}, {0.f, 0.f, 0.f, 0.f}};
    if (mode == 1) {
#pragma unroll
        for (int k = 0; k < 2; ++k) { const int i4 = tid + 512 * k, m = i4 >> 5, j4 = i4 & 31;
            if (m < n) sm4[k] = *(const f32x4*)(rgsum + ((size_t)(b * 32 + m) * 512 + ch0) * 2 + j4 * 4); }
    }
    {
        const int c = tid & 63, tg = tid >> 6, ch = ch0 + c;
        const float* cw = p.rg_conv_w + l * 4 * 512 + ch; const float w0 = cw[0], w1 = cw[512], w2 = cw[1024], w3 = cw[1536], cb = p.rg_conv_b[l * 512 + ch];
        float xv[11];
#pragma unroll
        for (int i = 0; i < 11; ++i) { const int ts = t0 + tg * 8 - 3 + i; xv[i] = ts >= 0 ? bf2f(proj[(size_t)(b * SEQ + ts) * NPROJ + COL_RGX + ch]) : 0.f; }
#pragma unroll
        for (int j = 0; j < 8; ++j) { const float v = w0 * xv[j] + w1 * xv[j + 1] + w2 * xv[j + 2] + w3 * xv[j + 3] + cb; const int t = tg * 8 + j; XC[t * 65 + c] = v; XC16[t * 72 + c] = f2bf(v); }
        const bf16_t* wsrc = (const bf16_t*)(p.ws + WS_WT16);
#pragma unroll
        for (int i = 0; i < 2; ++i) { const int ci = tid + 512 * i, rw = ci >> 3, sg = ci & 7, g = rw >> 6, d = rw & 63;
            *(u32x4*)(WT + rw * 72 + sg * 8) = *(const u32x4*)(wsrc + ((size_t)((l * 2 + g) * 8 + nb) * 64 + d) * 64 + sg * 8); }
    }
    __syncthreads();
    {
        const int tt = wid >> 1, dh = wid & 1;
        bf16x8 Af[2];
#pragma unroll
        for (int ks = 0; ks < 2; ++ks) Af[ks] = *(const bf16x8*)(XC16 + (tt * 16 + r) * 72 + ks * 32 + q * 8);
#pragma unroll
        for (int db = 0; db < 2; ++db) {
            const int dblk = dh * 2 + db;
            f32x4 ar = {0.f, 0.f, 0.f, 0.f}, ai = {0.f, 0.f, 0.f, 0.f};
#pragma unroll
            for (int ks = 0; ks < 2; ++ks) {
                ar = mfma16(Af[ks], *(const bf16x8*)(WT + (dblk * 16 + r) * 72 + ks * 32 + q * 8), ar);
                ai = mfma16(Af[ks], *(const bf16x8*)(WT + (64 + dblk * 16 + r) * 72 + ks * 32 + q * 8), ai);
            }
            const int d = dblk * 16 + r, ch = ch0 + d;
            const float br = p.rg_gate_b[l * 1024 + ch], bi = p.rg_gate_b[l * 1024 + 512 + ch], sp = softplus_(-p.rg_lambda[l * 512 + ch]);
#pragma unroll
            for (int j = 0; j < 4; ++j) {
                const int t = tt * 16 + q * 4 + j;
                const float rr = sigmoid_(ar[j] + br), ii = sigmoid_(ai[j] + bi), la = -8.0f * rr * sp, a = __expf(la);
                AA[t * 65 + d] = a; BB[t * 65 + d] = __builtin_amdgcn_sqrtf(neg_expm1_(2.0f * la)) * ii * XC[t * 65 + d];
            }
        }
    }
    __syncthreads();
    const int c = tid & 63, sg = tid >> 6;
    {
        float P = 1.f, H = 0.f;
#pragma unroll
        for (int j = 0; j < 8; ++j) { const int t = sg * 8 + j; const float a = AA[t * 65 + c]; H = a * H + BB[t * 65 + c]; P *= a; }
        SEG[(sg * 64 + c) * 2] = P; SEG[(sg * 64 + c) * 2 + 1] = H;
        if (mode == 1) {
#pragma unroll
            for (int k = 0; k < 2; ++k) *(f32x4*)(SUM + (tid + 512 * k) * 4) = sm4[k];
        }
    }
    __syncthreads();
    if (mode == 1) {
        if (tid < 64) { float h = 0.f; for (int m = 0; m < n; ++m) h = SUM[m * 128 + c * 2] * h + SUM[m * 128 + c * 2 + 1]; H0[c] = h; }
        __syncthreads();
    }
    float hin = mode == 1 ? H0[c] : 0.f;
    for (int s = 0; s < sg; ++s) hin = SEG[(s * 64 + c) * 2] * hin + SEG[(s * 64 + c) * 2 + 1];
    if (mode == 0) {
        if (sg == 7) { float pt = 1.f;
#pragma unroll
            for (int s = 0; s < 8; ++s) pt *= SEG[(s * 64 + c) * 2];
            const float hc = SEG[(7 * 64 + c) * 2] * hin + SEG[(7 * 64 + c) * 2 + 1];
            float* dst = rgsum + ((size_t)(b * 32 + n) * 512 + ch0 + c) * 2; dst[0] = pt; dst[1] = hc; }
    } else {
        float h = hin;
#pragma unroll
        for (int j = 0; j < 8; ++j) { const int t = sg * 8 + j; h = AA[t * 65 + c] * h + BB[t * 65 + c];
            const size_t ro = (size_t)(row0 + t) * NPROJ; const float z = bf2f(proj[ro + COL_RGZ + ch0 + c]);
            proj[ro + YOFF + ch0 + c] = f2bf(h * silu_(z)); }
    }
    __syncthreads();
}

__device__ __forceinline__ void rg_unit2(unsigned char* lds, const Params& p, int l, int b, int n, int mode) {
    const int tid = opaque_tid(), lane = tid & 63, nb = __builtin_amdgcn_readfirstlane(tid >> 6), r = lane & 15, q = lane >> 4;
    unsigned char* wl = lds + nb * 18432;
    bf16_t* XC16 = (bf16_t*)wl; float* AB = (float*)(wl + 10240);
    bf16_t* proj = (bf16_t*)(p.ws + WS_PROJ); float* rgsum = (float*)(p.ws + WS_RGSUM);
    const int row0 = b * SEQ + n * 64, ch0 = nb * 64;
    bf16x8 WF[2][4][2];
    {
        const bf16_t* wsrc = (const bf16_t*)(p.ws + WS_WT16);
#pragma unroll
        for (int g = 0; g < 2; ++g)
#pragma unroll
            for (int dblk = 0; dblk < 4; ++dblk)
#pragma unroll
                for (int ks = 0; ks < 2; ++ks) WF[g][dblk][ks] = *(const bf16x8*)(wsrc + ((size_t)((l * 2 + g) * 8 + nb) * 64 + dblk * 16 + r) * 64 + ks * 32 + q * 8);
    }
    float pbr[4], pbi[4], plam[4];
#pragma unroll
    for (int dblk = 0; dblk < 4; ++dblk) { const int ch = ch0 + dblk * 16 + r; pbr[dblk] = p.rg_gate_b[l * 1024 + ch]; pbi[dblk] = p.rg_gate_b[l * 1024 + 512 + ch]; plam[dblk] = p.rg_lambda[l * 512 + ch]; }
    float h0 = 0.f;
    if (mode == 1) {
        const float* sm = rgsum + ((size_t)(b * 32) * 512 + ch0 + lane) * 2;
#pragma unroll
        for (int mb = 0; mb < 2; ++mb) {
            f32x2v ab[16];
#pragma unroll
            for (int k = 0; k < 16; ++k) { const int m = mb * 16 + k; ab[k] = (f32x2v){1.f, 0.f}; if (m < n) ab[k] = *(const f32x2v*)(sm + (size_t)m * 1024); }
#pragma unroll
            for (int k = 0; k < 16; ++k) h0 = ab[k].x * h0 + ab[k].y;
        }
    }
    {
        const int t0 = (lane >> 3) * 8, ch8 = (lane & 7) * 8;
        const float* cw = p.rg_conv_w + l * 4 * 512 + ch0 + ch8; const float* cbp = p.rg_conv_b + l * 512 + ch0 + ch8;
        f32x4 wv[4][2], cb2[2];
#pragma unroll
        for (int k = 0; k < 4; ++k) { wv[k][0] = *(const f32x4*)(cw + k * 512); wv[k][1] = *(const f32x4*)(cw + k * 512 + 4); }
        cb2[0] = *(const f32x4*)cbp; cb2[1] = *(const f32x4*)(cbp + 4);
        const bf16_t* src = proj + (size_t)(row0 + t0 - 3) * NPROJ + COL_RGX + ch0 + ch8;
        u32x4 xr[11];
#pragma unroll
        for (int i = 0; i < 11; ++i) { xr[i] = (u32x4){0u, 0u, 0u, 0u}; if (n > 0 || t0 - 3 + i >= 0) xr[i] = *(const u32x4*)(src + (size_t)i * NPROJ); }
#pragma unroll
        for (int j = 0; j < 8; ++j) {
            float o[8];
#pragma unroll
            for (int e = 0; e < 8; ++e) {
                float acc = cb2[e >> 2][e & 3];
#pragma unroll
                for (int k = 0; k < 4; ++k) { const unsigned w = xr[j + k][e >> 1]; acc += wv[k][e >> 2][e & 3] * ((e & 1) ? bfhi(w) : bflo(w)); }
                o[e] = acc;
            }
            u32x4 w; w.x = pack2(o[0], o[1]); w.y = pack2(o[2], o[3]); w.z = pack2(o[4], o[5]); w.w = pack2(o[6], o[7]);
            *(u32x4*)(XC16 + (t0 + j) * 80 + ch8) = w;
        }
    }
    bf16x8 AF[4][2];
#pragma unroll
    for (int tt = 0; tt < 4; ++tt)
#pragma unroll
        for (int ks = 0; ks < 2; ++ks) AF[tt][ks] = *(const bf16x8*)(XC16 + (tt * 16 + r) * 80 + ks * 32 + q * 8);
#pragma unroll
    for (int dblk = 0; dblk < 4; ++dblk) {
        const int d = dblk * 16 + r, ch = ch0 + d;
        const float br = pbr[dblk], bi = pbi[dblk], sp = softplus_(-plam[dblk]);
#pragma unroll
        for (int tt = 0; tt < 4; ++tt) {
            f32x4 ar = {0.f, 0.f, 0.f, 0.f}, ai = {0.f, 0.f, 0.f, 0.f};
#pragma unroll
            for (int ks = 0; ks < 2; ++ks) { ar = mfma16(AF[tt][ks], WF[0][dblk][ks], ar); ai = mfma16(AF[tt][ks], WF[1][dblk][ks], ai); }
#pragma unroll
            for (int j = 0; j < 4; ++j) {
                const int t = tt * 16 + q * 4 + j;
                const float rr = sigmoid_(ar[j] + br), ii = sigmoid_(ai[j] + bi), la = -8.0f * rr * sp;
                f32x2v ab; ab.x = __expf(la);
                const float x2 = 2.0f * la, ser = -x2 * (1.f + x2 * (0.5f + x2 * (0.16666667f + x2 * (0.041666668f + x2 * (0.0083333338f + x2 * 0.0013888889f))))), big = 1.f - ab.x * ab.x;
                ab.y = __builtin_amdgcn_sqrtf(x2 > -0.25f ? ser : big) * ii * bf2f(XC16[t * 80 + d]);
                *(f32x2v*)(AB + (t * 16 + r) * 2) = ab;
            }
        }
        const float hc = __shfl(h0, dblk * 16 + r);
        if (lane < 16) {
            float h = hc, P = 1.f;
#pragma unroll 8
            for (int t = 0; t < 64; ++t) { const f32x2v ab = *(const f32x2v*)(AB + (t * 16 + lane) * 2); h = ab.x * h + ab.y; P *= ab.x; if (mode == 1) AB[(t * 16 + lane) * 2] = h; }
            if (mode == 0) { float* dst = rgsum + ((size_t)(b * 32 + n) * 512 + ch) * 2; dst[0] = P; dst[1] = h; }
        }
        if (mode == 1) {
#pragma unroll
            for (int i = 0; i < 16; ++i) { const int t = i * 4 + q; const float h = AB[(t * 16 + r) * 2];
                const size_t ro = (size_t)(row0 + t) * NPROJ; const float z = bf2f(proj[ro + COL_RGZ + ch]);
                proj[ro + YOFF + ch] = f2bf(h * silu_(z)); }
        }
    }
    __syncthreads();
}

__device__ __forceinline__ void ml_m1(unsigned char* lds, const Params& p, int l, int b, int h, int n) {
    const int tid = opaque_tid(), lane = tid & 63, wid = tid >> 6, r = lane & 15, q = lane >> 4;
    bf16_t* Q16 = (bf16_t*)lds; bf16_t* K16 = (bf16_t*)(lds + 17408); bf16_t* VT16 = (bf16_t*)(lds + 34816); bf16_t* KTw = (bf16_t*)(lds + 53248); bf16_t* SP16 = (bf16_t*)(lds + 71680);
    float* LI = (float*)(lds + 80896); float* BC = LI + 64; float* ML = BC + 64; float* WK = ML + 64; float* DENP = WK + 64; float* MISC = DENP + 256;
    bf16_t* proj = (bf16_t*)(p.ws + WS_PROJ); const float* gates = (const float*)(p.ws + WS_GATES);
    unsigned char* rec = p.ws + WS_MLREC + (size_t)((b * 4 + h) * 32 + n) * MLREC_BYTES;
    const int row0 = b * SEQ + n * 64;
    if (wid == 0) {
        const int t = lane; const float* gp = gates + (size_t)(row0 + t) * 16;
        const float li = gp[h] + p.ml_gate_b[l * 8 + h], fp = gp[4 + h] + p.ml_gate_b[l * 8 + 4 + h];
        const float lf = -softplus_(-fp), bc = wave_incl_sum(lf, lane), pm = wave_incl_max(li - bc, lane), ml = bc + pm;
        const float g = __builtin_bit_cast(float, __builtin_amdgcn_readlane(__builtin_bit_cast(int, bc), 63)), ws = g - bc + li, mw = wave_max(ws);
        LI[t] = li; BC[t] = bc; ML[t] = ml; WK[t] = __expf(ws - mw);
        if (t == 0) { MISC[0] = g; MISC[1] = mw; }
    }
    if (tid >= 256) DENP[tid - 256] = 0.f;
    u32x4 kreg[2];
#pragma unroll
    for (int i = 0; i < 2; ++i) {
        const int wv = (tid >> 6) + 8 * i, rw = (wv & 3) * 16 + (lane & 15), sg = (wv >> 2) * 4 + (lane >> 4); const bf16_t* base = proj + (size_t)(row0 + rw) * NPROJ + h * 128 + sg * 8;
        const u32x4 qv = *(const u32x4*)(base + COL_MLQ), kv = *(const u32x4*)(base + COL_MLK), vv = *(const u32x4*)(base + COL_MLV);
        *(u32x4*)(Q16 + rw * 136 + sg * 8) = qv; *(u32x4*)(K16 + rw * 136 + sg * 8) = kv; kreg[i] = kv;
#pragma unroll
        for (int e = 0; e < 8; ++e) VT16[(sg * 8 + e) * 72 + rw] = (bf16_t)(vv[e >> 1] >> ((e & 1) * 16));
    }
    __syncthreads();
#pragma unroll
    for (int i = 0; i < 2; ++i) {
        const int wv = (tid >> 6) + 8 * i, rw = (wv & 3) * 16 + (lane & 15), sg = (wv >> 2) * 4 + (lane >> 4); const float wk = WK[rw];
#pragma unroll
        for (int e = 0; e < 8; ++e) KTw[(sg * 8 + e) * 72 + rw] = f2bf(bf2f((bf16_t)(kreg[i][e >> 1] >> ((e & 1) * 16))) * wk);
    }
    {
        const int tt = wid >> 1;
#pragma unroll
        for (int hf = 0; hf < 2; ++hf) {
            const int st = (wid & 1) * 2 + hf, s = st * 16 + r;
            if (st > tt) {
#pragma unroll
                for (int j = 0; j < 4; ++j) SP16[(tt * 16 + q * 4 + j) * 72 + s] = 0;
                continue;
            }
            f32x4 acc = {0.f, 0.f, 0.f, 0.f};
#pragma unroll
            for (int ks = 0; ks < 4; ++ks) acc = mfma16(*(const bf16x8*)(Q16 + (tt * 16 + r) * 136 + ks * 32 + q * 8), *(const bf16x8*)(K16 + (st * 16 + r) * 136 + ks * 32 + q * 8), acc);
            const float bs = BC[s], lis = LI[s];
#pragma unroll
            for (int j = 0; j < 4; ++j) {
                const int t = tt * 16 + q * 4 + j;
                const float sp = s <= t ? acc[j] * QSCALE * __expf(BC[t] - bs + lis - ML[t]) : 0.f;
                const float v = sum16_dpp(sp);
                if (r == 0) DENP[t * 4 + st] = v;
                SP16[t * 72 + s] = f2bf(sp);
            }
        }
    }
    __syncthreads();
    {
        const int eb = wid; bf16x8 Bf[2];
#pragma unroll
        for (int ks = 0; ks < 2; ++ks) Bf[ks] = *(const bf16x8*)(VT16 + (eb * 16 + r) * 72 + ks * 32 + q * 8);
        bf16_t* inum = (bf16_t*)rec; bf16_t* gate = (bf16_t*)(rec + 16384);
#pragma unroll
        for (int tt = 0; tt < 4; ++tt) {
            f32x4 acc = {0.f, 0.f, 0.f, 0.f};
#pragma unroll
            for (int ks = 0; ks < 2; ++ks) acc = mfma16(*(const bf16x8*)(SP16 + (tt * 16 + r) * 72 + ks * 32 + q * 8), Bf[ks], acc);
            u32x2 w; w.x = pack2(acc[0], acc[1]); w.y = pack2(acc[2], acc[3]);
            *(u32x2*)(inum + ((eb * 4 + tt) * 64 + lane) * 4) = w;
            float gv[4];
#pragma unroll
            for (int j = 0; j < 4; ++j) { const size_t ro = (size_t)(row0 + tt * 16 + q * 4 + j) * NPROJ + h * 128 + eb * 16 + r;
                gv[j] = sigmoid_(bf2f(proj[ro + COL_MLO])) * silu_(bf2f(proj[ro + COL_MLZ])); }
#pragma unroll
            for (int j = 0; j < 4; ++j) gate[(tt * 16 + q * 4 + j) * 128 + eb * 16 + r] = f2bf(gv[j]);
        }
#pragma unroll
        for (int dblk = 0; dblk < 8; ++dblk) {
            f32x4 acc = {0.f, 0.f, 0.f, 0.f};
#pragma unroll
            for (int ks = 0; ks < 2; ++ks) acc = mfma16(*(const bf16x8*)(KTw + (dblk * 16 + r) * 72 + ks * 32 + q * 8), Bf[ks], acc);
            u32x2 w; w.x = pack2(acc[0], acc[1]); w.y = pack2(acc[2], acc[3]);
            const int ti = eb * 8 + dblk;
            bf16_t* dst = proj + (size_t)(row0 + ti) * NPROJ + h * 128 + (lane < 32 ? COL_MLK + lane * 4 : COL_MLV + (lane - 32) * 4);
            *(u32x2*)dst = w;
        }
    }
    float* sc = (float*)(rec + 32768);
    if (tid < 64) { const int t = tid; sc[t] = ML[t]; sc[64 + t] = BC[t]; sc[128 + t] = (DENP[t * 4] + DENP[t * 4 + 1]) + (DENP[t * 4 + 2] + DENP[t * 4 + 3]); }
    else if (tid < 192) { const int d = tid - 64; float s = 0.f;
#pragma unroll
        for (int i = 0; i < 8; ++i) { const u32x4 w = *(const u32x4*)(KTw + d * 72 + i * 8);
#pragma unroll
            for (int k = 0; k < 4; ++k) s += bflo(w[k]) + bfhi(w[k]); }
        sc[192 + d] = s; }
    else if (tid == 192) { sc[320] = MISC[0]; sc[321] = MISC[1]; }
    __syncthreads();
}

__device__ __forceinline__ void ml_m1c(unsigned char* lds, const Params& p, int l, int b, int h, int n) {
    const int tid = opaque_tid(), t8 = tid & 255, lane = tid & 63, w4 = (tid >> 6) & 3, r = lane & 15, q = lane >> 4;
    unsigned char* hl = lds + (tid >> 8) * 79872;
    bf16_t* Q16 = (bf16_t*)hl; bf16_t* K16 = (bf16_t*)(hl + 17408); bf16_t* VT16 = (bf16_t*)(hl + 34816); bf16_t* KTw = (bf16_t*)(hl + 55296); bf16_t* SP16 = (bf16_t*)hl;
    float* LI = (float*)(hl + 75776); float* BC = LI + 64; float* ML = BC + 64; float* WK = ML + 64; float* DENP = WK + 64; float* MISC = DENP + 256;
    bf16_t* proj = (bf16_t*)(p.ws + WS_PROJ); const float* gates = (const float*)(p.ws + WS_GATES);
    unsigned char* rec = p.ws + WS_MLREC + (size_t)((b * 4 + h) * 32 + n) * MLREC_BYTES;
    const int row0 = b * SEQ + n * 64;
    if (w4 == 0) {
        const int t = lane; const float* gp = gates + (size_t)(row0 + t) * 16;
        const float li = gp[h] + p.ml_gate_b[l * 8 + h], fp = gp[4 + h] + p.ml_gate_b[l * 8 + 4 + h];
        const float lf = -softplus_(-fp), bc = wave_incl_sum(lf, lane), pm = wave_incl_max(li - bc, lane), ml = bc + pm;
        const float g = __builtin_bit_cast(float, __builtin_amdgcn_readlane(__builtin_bit_cast(int, bc), 63)), ws = g - bc + li, mw = wave_max(ws);
        LI[t] = li; BC[t] = bc; ML[t] = ml; WK[t] = __expf(ws - mw);
        if (t == 0) { MISC[0] = g; MISC[1] = mw; }
    }
    DENP[t8] = 0.f;
    u32x4 go[2][2], gz[2][2];
#pragma unroll
    for (int k2 = 0; k2 < 2; ++k2) { const int task = t8 + 256 * k2, t = task >> 3, grp = task & 7; const bf16_t* gbase = proj + (size_t)(row0 + t) * NPROJ + h * 128 + grp * 16;
        go[k2][0] = *(const u32x4*)(gbase + COL_MLO); go[k2][1] = *(const u32x4*)(gbase + COL_MLO + 8); gz[k2][0] = *(const u32x4*)(gbase + COL_MLZ); gz[k2][1] = *(const u32x4*)(gbase + COL_MLZ + 8); }
    u32x4 kreg[4];
#pragma unroll
    for (int i = 0; i < 4; ++i) {
        const int wv = w4 + 4 * i, rw = (wv & 3) * 16 + (lane & 15), sg = (wv >> 2) * 4 + (lane >> 4); const bf16_t* base = proj + (size_t)(row0 + rw) * NPROJ + h * 128 + sg * 8;
        const u32x4 qv = *(const u32x4*)(base + COL_MLQ), kv = *(const u32x4*)(base + COL_MLK), vv = *(const u32x4*)(base + COL_MLV);
        *(u32x4*)(Q16 + rw * 136 + sg * 8) = qv; *(u32x4*)(K16 + rw * 136 + sg * 8) = kv; kreg[i] = kv;
#pragma unroll
        for (int e = 0; e < 8; ++e) VT16[(sg * 8 + e) * 80 + rw] = (bf16_t)(vv[e >> 1] >> ((e & 1) * 16));
    }
    __syncthreads();
    {
        bf16_t* gate = (bf16_t*)(rec + 16384);
#pragma unroll
        for (int k2 = 0; k2 < 2; ++k2) { const int task = t8 + 256 * k2, t = task >> 3, grp = task & 7;
#pragma unroll
            for (int i = 0; i < 2; ++i) { u32x4 w;
#pragma unroll
                for (int k = 0; k < 4; ++k) {
                    const float o0 = bflo(go[k2][i][k]), o1 = bfhi(go[k2][i][k]), z0 = bflo(gz[k2][i][k]), z1 = bfhi(gz[k2][i][k]);
                    w[k] = pack2(z0 * __builtin_amdgcn_rcpf((1.f + __expf(-o0)) * (1.f + __expf(-z0))), z1 * __builtin_amdgcn_rcpf((1.f + __expf(-o1)) * (1.f + __expf(-z1)))); }
                *(u32x4*)(gate + t * 128 + grp * 16 + i * 8) = w; } }
    }
#pragma unroll
    for (int i = 0; i < 4; ++i) {
        const int wv = w4 + 4 * i, rw = (wv & 3) * 16 + (lane & 15), sg = (wv >> 2) * 4 + (lane >> 4); const float wk = WK[rw];
#pragma unroll
        for (int e = 0; e < 8; ++e) KTw[(sg * 8 + e) * 80 + rw] = f2bf(bf2f((bf16_t)(kreg[i][e >> 1] >> ((e & 1) * 16))) * wk);
    }
    float spv[4][4];
    {
        const int tt = w4;
#pragma unroll
        for (int st = 0; st < 4; ++st) {
            const int s = st * 16 + r;
#pragma unroll
            for (int j = 0; j < 4; ++j) spv[st][j] = 0.f;
            if (st <= tt) {
                f32x4 acc = {0.f, 0.f, 0.f, 0.f};
#pragma unroll
                for (int ks = 0; ks < 4; ++ks) acc = mfma16(*(const bf16x8*)(Q16 + (tt * 16 + r) * 136 + ks * 32 + q * 8), *(const bf16x8*)(K16 + (st * 16 + r) * 136 + ks * 32 + q * 8), acc);
                const float bs = BC[s], lis = LI[s];
#pragma unroll
                for (int j = 0; j < 4; ++j) {
                    const int t = tt * 16 + q * 4 + j;
                    const float sp = s <= t ? acc[j] * QSCALE * __expf(BC[t] - bs + lis - ML[t]) : 0.f;
                    const float v = sum16_dpp(sp);
                    if (r == 0) DENP[t * 4 + st] = v;
                    spv[st][j] = sp;
                }
            }
        }
    }
    __syncthreads();
#pragma unroll
    for (int st = 0; st < 4; ++st)
#pragma unroll
        for (int j = 0; j < 4; ++j) SP16[(w4 * 16 + q * 4 + j) * 80 + st * 16 + r] = f2bf(spv[st][j]);
    __syncthreads();
#pragma unroll
    for (int e2 = 0; e2 < 2; ++e2) {
        const int eb = w4 * 2 + e2; bf16x8 Bf[2];
#pragma unroll
        for (int ks = 0; ks < 2; ++ks) Bf[ks] = *(const bf16x8*)(VT16 + (eb * 16 + r) * 80 + ks * 32 + q * 8);
        bf16_t* inum = (bf16_t*)rec;
#pragma unroll
        for (int tt = 0; tt < 4; ++tt) {
            f32x4 acc = {0.f, 0.f, 0.f, 0.f};
#pragma unroll
            for (int ks = 0; ks < 2; ++ks) acc = mfma16(*(const bf16x8*)(SP16 + (tt * 16 + r) * 80 + ks * 32 + q * 8), Bf[ks], acc);
            u32x2 w; w.x = pack2(acc[0], acc[1]); w.y = pack2(acc[2], acc[3]);
            *(u32x2*)(inum + ((eb * 4 + tt) * 64 + lane) * 4) = w;
        }
#pragma unroll
        for (int dblk = 0; dblk < 8; ++dblk) {
            f32x4 acc = {0.f, 0.f, 0.f, 0.f};
#pragma unroll
            for (int ks = 0; ks < 2; ++ks) acc = mfma16(*(const bf16x8*)(KTw + (dblk * 16 + r) * 80 + ks * 32 + q * 8), Bf[ks], acc);
            u32x2 w; w.x = pack2(acc[0], acc[1]); w.y = pack2(acc[2], acc[3]);
            const int ti = eb * 8 + dblk;
            bf16_t* dst = proj + (size_t)(row0 + ti) * NPROJ + h * 128 + (lane < 32 ? COL_MLK + lane * 4 : COL_MLV + (lane - 32) * 4);
            *(u32x2*)dst = w;
        }
    }
    float* sc = (float*)(rec + 32768);
    if (t8 < 64) { const int t = t8; sc[t] = ML[t]; sc[64 + t] = BC[t]; sc[128 + t] = (DENP[t * 4] + DENP[t * 4 + 1]) + (DENP[t * 4 + 2] + DENP[t * 4 + 3]); }
    else if (t8 < 192) { const int d = t8 - 64; float s = 0.f;
#pragma unroll
        for (int i = 0; i < 8; ++i) { const u32x4 w = *(const u32x4*)(KTw + d * 80 + i * 8);
#pragma unroll
            for (int k = 0; k < 4; ++k) s += bflo(w[k]) + bfhi(w[k]); }
        sc[192 + d] = s; }
    else if (t8 == 192) { sc[320] = MISC[0]; sc[321] = MISC[1]; }
    __syncthreads();
}

#ifndef GD_VALU_SOLVE
#define GD_VALU_SOLVE 0
#endif
__device__ __forceinline__ void gd_m1(unsigned char* lds, const Params& p, int l, int b, int h, int n) {
    const int tid = opaque_tid(), lane = tid & 63, wid = tid >> 6, r = lane & 15, q = lane >> 4;
    bf16_t* Q16 = (bf16_t*)lds; bf16_t* K16 = (bf16_t*)(lds + 17408); float* MM = (float*)(lds + 34816);
    float* BETA = (float*)(lds + 51200); float* GC = BETA + 64; float* EGC = GC + 64; float* EKD = EGC + 64; float* SSP = EKD + 64; float* RN = SSP + 256;
    bf16_t* proj = (bf16_t*)(p.ws + WS_PROJ); const float* gates = (const float*)(p.ws + WS_GATES);
    unsigned char* rec = p.ws + WS_GDREC + (size_t)((b * 4 + h) * 32 + n) * GDREC_BYTES;
    const int row0 = b * SEQ + n * 64, sel = tid >> 7, ch = tid & 127;
    float* VS = (float*)lds;
    bf16_t* MP16 = (bf16_t*)(lds + 120320);
    bf16_t* TP16 = (bf16_t*)(lds + 129536);
    for (int i = tid; i < 896; i += 512) *(u32x4*)(lds + 120320 + i * 16) = (u32x4){0u, 0u, 0u, 0u};
    float val[64];
    if (sel < 3) {
        const float* cw = p.gd_conv_w + (size_t)l * 4 * 1536 + sel * 512 + h * 128 + ch; const float w0 = cw[0], w1 = cw[1536], w2 = cw[3072], w3 = cw[4608];
        const bf16_t* src = proj + (size_t)row0 * NPROJ + COL_GDQ + sel * 512 + h * 128 + ch;
        float xm3 = 0.f, xm2 = 0.f, xm1 = 0.f;
        if (n > 0) { xm3 = bf2f(src[-3 * NPROJ]); xm2 = bf2f(src[-2 * NPROJ]); xm1 = bf2f(src[-1 * NPROJ]); }
#pragma unroll
        for (int t = 0; t < 64; ++t) { const float x = bf2f(src[(size_t)t * NPROJ]); val[t] = silu_(w0 * xm3 + w1 * xm2 + w2 * xm1 + w3 * x); xm3 = xm2; xm2 = xm1; xm1 = x; }
    } else {
#pragma unroll
        for (int t = 0; t < 64; ++t) val[t] = 0.f;
        if (wid == 7) {
            const int t = lane; const float* gp = gates + (size_t)(row0 + t) * 16;
            const float beta = sigmoid_(gp[12 + h]), g = -__expf(p.gd_a_log[l * 4 + h]) * softplus_(gp[8 + h] + p.gd_dt_bias[l * 4 + h]);
            const float gc = wave_incl_sum(g, lane), gl = __builtin_bit_cast(float, __builtin_amdgcn_readlane(__builtin_bit_cast(int, gc), 63));
            BETA[t] = beta; GC[t] = gc; EGC[t] = __expf(gc); EKD[t] = __expf(gl - gc);
        }
    }
    float* XS = (float*)(lds + 54272);
    if (sel < 2) {
#pragma unroll
        for (int t = 0; t < 64; ++t) XS[(sel * 64 + t) * 129 + ch] = val[t];
    }
    __syncthreads();
    {
        const int s2 = tid >> 8, t = (tid >> 2) & 63, part = tid & 3; const float* xr = XS + (s2 * 64 + t) * 129 + part * 32; float ss = 0.f;
#pragma unroll
        for (int i = 0; i < 32; ++i) ss += xr[i] * xr[i];
        ss += __shfl_xor(ss, 1); ss += __shfl_xor(ss, 2);
        if (part == 0) { float rn = rsqrtf(ss + EPS); if (s2 == 0) rn *= QSCALE; RN[s2 * 64 + t] = rn; }
    }
    __syncthreads();
    if (sel < 2) {
        bf16_t* dst = sel == 0 ? Q16 : K16;
#pragma unroll
        for (int t = 0; t < 64; ++t) { val[t] *= RN[sel * 64 + t]; dst[t * 136 + ch] = f2bf(val[t]); }
    }
    __syncthreads();
#pragma unroll
    for (int jj = 0; jj < 4; ++jj) {
        const int idx = wid * 4 + jj, which = idx >> 4, tt = (idx >> 2) & 3, st = idx & 3;
        if (which == 0 && st > tt) continue;
        f32x4 acc = {0.f, 0.f, 0.f, 0.f};
        if (st <= tt) {
            const bf16_t* Ab = which ? Q16 : K16;
#pragma unroll
            for (int ks = 0; ks < 4; ++ks) acc = mfma16(*(const bf16x8*)(Ab + (tt * 16 + r) * 136 + ks * 32 + q * 8), *(const bf16x8*)(K16 + (st * 16 + r) * 136 + ks * 32 + q * 8), acc);
        }
        const int s = st * 16 + r; const float gcs = GC[s];
        bf16_t* aq = (bf16_t*)(rec + 49152);
#pragma unroll
        for (int j = 0; j < 4; ++j) {
            const int t = tt * 16 + q * 4 + j;
            if (which == 0) { const float mv = s < t ? BETA[t] * acc[j] * __expf(GC[t] - gcs) : 0.f; MM[t * 64 + s] = mv; MP16[t * 72 + (st >> 1) * 32 + permpos(s & 31)] = f2bf(mv); }
            else aq[t * 64 + (st >> 1) * 32 + permpos(s & 31)] = f2bf(s <= t ? acc[j] * __expf(GC[t] - gcs) : 0.f);
        }
    }
    __syncthreads();
    const int pos = (ch & ~31) + permpos(ch & 31);
    if (sel == 0) { bf16_t* qd = (bf16_t*)(rec + 16384);
#pragma unroll
        for (int t = 0; t < 64; ++t) qd[t * 128 + pos] = f2bf(val[t] * EGC[t]); }
    if (sel == 1) {
        bf16_t* kd = (bf16_t*)(rec + 32768) + ch * 64;
#pragma unroll
        for (int p4 = 0; p4 < 16; ++p4) {
            const int pp = (p4 * 4) & 31, s0 = ((p4 * 4) >> 5) * 32 + ((pp >> 2) & 1) * 16 + (pp >> 3) * 4;
            u32x2 w; w.x = pack2(val[s0] * EKD[s0], val[s0 + 1] * EKD[s0 + 1]); w.y = pack2(val[s0 + 2] * EKD[s0 + 2], val[s0 + 3] * EKD[s0 + 3]);
            *(u32x2*)(kd + p4 * 4) = w;
        }
#pragma unroll
        for (int t = 0; t < 64; ++t) val[t] *= BETA[t] * EGC[t];
    }
#if GD_VALU_SOLVE
    if (sel == 2) {
#pragma unroll
        for (int t = 0; t < 64; ++t) val[t] *= BETA[t];
    }
    if (sel == 1 || sel == 2) {
#pragma unroll
        for (int t = 1; t < 64; ++t) {
            float a = val[t];
#pragma unroll
            for (int s4 = 0; s4 < (t + 3) / 4; ++s4) { const f32x4 m = *(const f32x4*)(MM + t * 64 + s4 * 4);
                a -= m[0] * val[s4 * 4]; a -= m[1] * val[s4 * 4 + 1]; a -= m[2] * val[s4 * 4 + 2]; a -= m[3] * val[s4 * 4 + 3]; }
            val[t] = a;
        }
    }
    if (sel == 2) { bf16_t* up = (bf16_t*)(rec + 57344); const int eb = ch >> 4, c = ch & 15;
#pragma unroll
        for (int t = 0; t < 64; ++t) up[((eb * 4 + (t >> 4)) * 64 + ((t >> 2) & 3) * 16 + c) * 4 + (t & 3)] = f2bf(val[t]); }
    if (sel == 1) { bf16_t* wp = (bf16_t*)rec;
#pragma unroll
        for (int t = 0; t < 64; ++t) wp[t * 128 + pos] = f2bf(val[t]); }
    if (tid == 511) *(float*)(rec + 73728) = GC[63];
    __syncthreads();
#else
    (void)r; (void)q;
    if (sel == 2) {
#pragma unroll
        for (int t = 0; t < 64; ++t) VS[t * 136 + ch] = val[t];
    }
    if (tid < 64) {
        const int bi = tid >> 4, c = tid & 15; float x[16];
#pragma unroll
        for (int t = 0; t < 16; ++t) x[t] = (t == c) ? 1.f : 0.f;
#pragma unroll
        for (int t = 1; t < 16; ++t) { float a = x[t];
#pragma unroll
            for (int s2 = 0; s2 < t; ++s2) a -= MM[(bi * 16 + t) * 64 + bi * 16 + s2] * x[s2];
            x[t] = a; }
#pragma unroll
        for (int t = 0; t < 16; ++t) TP16[(bi * 16 + t) * 40 + ((c >> 2) & 3) * 8 + (c & 3)] = f2bf(x[t]);
    }
    __syncthreads();
    {
#pragma unroll
        for (int ci = 0; ci < 2; ++ci) {
            const int ct = wid * 2 + ci, c = ct * 16 + r;
            f32x4 X[4];
#pragma unroll
            for (int bi = 0; bi < 4; ++bi) {
                f32x4 z = {0.f, 0.f, 0.f, 0.f};
#pragma unroll
                for (int kk = 0; kk < 2; ++kk) {
                    if (2 * kk < bi) {
                        const f32x4 zero = {0.f, 0.f, 0.f, 0.f};
                        const bf16x8 Bop = pack_b(X[2 * kk], (2 * kk + 1 < bi) ? X[2 * kk + 1] : zero);
                        z = mfma16(*(const bf16x8*)(MP16 + (bi * 16 + r) * 72 + kk * 32 + q * 8), Bop, z);
                    }
                }
#pragma unroll
                for (int j = 0; j < 4; ++j) { const int t = bi * 16 + q * 4 + j;
                    const float rv = ct < 8 ? VS[t * 136 + c] * BETA[t] : XS[(64 + t) * 129 + (c - 128)] * RN[64 + t] * BETA[t] * EGC[t];
                    z[j] = rv - z[j]; }
                const f32x4 zero = {0.f, 0.f, 0.f, 0.f};
                X[bi] = mfma16(*(const bf16x8*)(TP16 + (bi * 16 + r) * 40 + q * 8), pack_b(z, zero), zero);
            }
            if (ct < 8) { bf16_t* up = (bf16_t*)(rec + 57344);
#pragma unroll
                for (int bi = 0; bi < 4; ++bi) { u32x2 w; w.x = pack2(X[bi][0], X[bi][1]); w.y = pack2(X[bi][2], X[bi][3]); *(u32x2*)(up + ((ct * 4 + bi) * 64 + lane) * 4) = w; }
            } else { bf16_t* wp = (bf16_t*)rec; const int d = c - 128, pd = (d & ~31) + permpos(d & 31);
#pragma unroll
                for (int bi = 0; bi < 4; ++bi)
#pragma unroll
                    for (int j = 0; j < 4; ++j) wp[(bi * 16 + q * 4 + j) * 128 + pd] = f2bf(X[bi][j]); }
        }
    }
    if (tid == 511) *(float*)(rec + 73728) = GC[63];
    __syncthreads();
#endif
}

__device__ __forceinline__ void gd_m1b(unsigned char* lds, const Params& p, int l, int b, int h, int n) {
    const int tid = opaque_tid(), lane = tid & 63, wid = tid >> 6, r = lane & 15, q = lane >> 4;
    bf16_t* Q16 = (bf16_t*)lds; bf16_t* K16 = (bf16_t*)(lds + 17408);
    float* MMD = (float*)(lds + 34816);
    float* BETA = (float*)(lds + 38912); float* GC = BETA + 64; float* EGC = GC + 64; float* EKD = EGC + 64; float* RN = EKD + 64;
    float* XS = (float*)(lds + 41472);
    bf16_t* MP16 = (bf16_t*)(lds + 140544);
    bf16_t* TP16 = (bf16_t*)(lds + 149760);
    bf16_t* proj = (bf16_t*)(p.ws + WS_PROJ); const float* gates = (const float*)(p.ws + WS_GATES);
    unsigned char* rec = p.ws + WS_GDREC + (size_t)((b * 4 + h) * 32 + n) * GDREC_BYTES;
    const int row0 = b * SEQ + n * 64;
    for (int i = tid; i < 896; i += 512) *(u32x4*)(lds + 140544 + i * 16) = (u32x4){0u, 0u, 0u, 0u};
    if (tid < 384) {
        const int ts = tid / 48, cg = tid - ts * 48, sel = cg >> 4, ch8 = (cg & 15) * 8, t0 = ts * 8;
        const float* cw = p.gd_conv_w + (size_t)l * 4 * 1536 + sel * 512 + h * 128 + ch8;
        f32x4 wv[4][2];
#pragma unroll
        for (int k = 0; k < 4; ++k) { wv[k][0] = *(const f32x4*)(cw + k * 1536); wv[k][1] = *(const f32x4*)(cw + k * 1536 + 4); }
        const bf16_t* src = proj + (size_t)(row0 + t0 - 3) * NPROJ + COL_GDQ + sel * 512 + h * 128 + ch8;
        u32x4 xr[11];
#pragma unroll
        for (int i = 0; i < 11; ++i) { xr[i] = (u32x4){0u, 0u, 0u, 0u}; if (n > 0 || t0 - 3 + i >= 0) xr[i] = *(const u32x4*)(src + (size_t)i * NPROJ); }
#pragma unroll
        for (int j = 0; j < 8; ++j) {
            float* dst = XS + (sel * 64 + t0 + j) * 129 + ch8;
#pragma unroll
            for (int e = 0; e < 8; ++e) {
                float a = 0.f;
#pragma unroll
                for (int k = 0; k < 4; ++k) { const unsigned w = xr[j + k][e >> 1]; a += wv[k][e >> 2][e & 3] * ((e & 1) ? bfhi(w) : bflo(w)); }
                dst[e] = silu_(a);
            }
        }
    } else if (wid == 7) {
        const int t = lane; const float* gp = gates + (size_t)(row0 + t) * 16;
        const float beta = sigmoid_(gp[12 + h]), g = -__expf(p.gd_a_log[l * 4 + h]) * softplus_(gp[8 + h] + p.gd_dt_bias[l * 4 + h]);
        const float gc = wave_incl_sum(g, lane), gl = __builtin_bit_cast(float, __builtin_amdgcn_readlane(__builtin_bit_cast(int, gc), 63));
        BETA[t] = beta; GC[t] = gc; EGC[t] = __expf(gc); EKD[t] = __expf(gl - gc);
    }
    __syncthreads();
    {
        const int s2 = tid >> 8, t = (tid >> 2) & 63, part = tid & 3; const float* xr = XS + (s2 * 64 + t) * 129 + part * 32; float v[32]; float ss = 0.f;
#pragma unroll
        for (int i = 0; i < 32; ++i) { v[i] = xr[i]; ss += v[i] * v[i]; }
        ss = sum4_dpp(ss);
        float rn = rsqrtf(ss + EPS); if (s2 == 0) rn *= QSCALE;
        if (part == 0) RN[s2 * 64 + t] = rn;
        bf16_t* dst = (s2 ? K16 : Q16) + t * 136 + part * 32;
#pragma unroll
        for (int i = 0; i < 4; ++i) { u32x4 w; w.x = pack2(v[i * 8] * rn, v[i * 8 + 1] * rn); w.y = pack2(v[i * 8 + 2] * rn, v[i * 8 + 3] * rn); w.z = pack2(v[i * 8 + 4] * rn, v[i * 8 + 5] * rn); w.w = pack2(v[i * 8 + 6] * rn, v[i * 8 + 7] * rn);
            *(u32x4*)(dst + i * 8) = w; }
    }
    __syncthreads();
#pragma unroll
    for (int jj = 0; jj < 4; ++jj) {
        const int idx = wid * 4 + jj, which = idx >> 4, tt = (idx >> 2) & 3, st = idx & 3;
        if (which == 0 && st > tt) continue;
        f32x4 acc = {0.f, 0.f, 0.f, 0.f};
        if (st <= tt) {
            const bf16_t* Ab = which ? Q16 : K16;
#pragma unroll
            for (int ks = 0; ks < 4; ++ks) acc = mfma16(*(const bf16x8*)(Ab + (tt * 16 + r) * 136 + ks * 32 + q * 8), *(const bf16x8*)(K16 + (st * 16 + r) * 136 + ks * 32 + q * 8), acc);
        }
        const int s = st * 16 + r; const float gcs = GC[s];
        bf16_t* aq = (bf16_t*)(rec + 49152);
#pragma unroll
        for (int j = 0; j < 4; ++j) {
            const int t = tt * 16 + q * 4 + j;
            if (which == 0) { const float mv = s < t ? BETA[t] * acc[j] * __expf(GC[t] - gcs) : 0.f; if (st == tt) MMD[(tt * 16 + q * 4 + j) * 16 + r] = mv; MP16[t * 72 + (st >> 1) * 32 + permpos(s & 31)] = f2bf(mv); }
            else aq[t * 64 + (st >> 1) * 32 + permpos(s & 31)] = f2bf(s <= t ? acc[j] * __expf(GC[t] - gcs) : 0.f);
        }
    }
    __syncthreads();
    if (tid < 64) {
        const int bi = tid >> 4, c = tid & 15; float x[16];
#pragma unroll
        for (int t = 0; t < 16; ++t) x[t] = (t == c) ? 1.f : 0.f;
#pragma unroll
        for (int t = 1; t < 16; ++t) { float a = x[t];
#pragma unroll
            for (int s2 = 0; s2 < t; ++s2) a -= MMD[(bi * 16 + t) * 16 + s2] * x[s2];
            x[t] = a; }
#pragma unroll
        for (int t = 0; t < 16; ++t) TP16[(bi * 16 + t) * 40 + ((c >> 2) & 3) * 8 + (c & 3)] = f2bf(x[t]);
    }
    {
        const int t = tid >> 3, grp = tid & 7; const float* xr = XS + t * 129 + grp * 16; const float sc = RN[t] * EGC[t];
        bf16_t* qd = (bf16_t*)(rec + 16384) + t * 128 + (grp >> 1) * 32;
#pragma unroll
        for (int rr = 0; rr < 4; ++rr) { u32x2 w; w.x = pack2(xr[rr * 4] * sc, xr[rr * 4 + 1] * sc); w.y = pack2(xr[rr * 4 + 2] * sc, xr[rr * 4 + 3] * sc);
            *(u32x2*)(qd + (rr * 2 + (grp & 1)) * 4) = w; }
    }
    if (tid >= 128 && tid < 256) {
        const int d = tid - 128; bf16_t* kd = (bf16_t*)(rec + 32768) + d * 64;
#pragma unroll
        for (int p4 = 0; p4 < 16; ++p4) {
            const int pp = (p4 * 4) & 31, s0 = ((p4 * 4) >> 5) * 32 + ((pp >> 2) & 1) * 16 + (pp >> 3) * 4;
            float kv[4];
#pragma unroll
            for (int i = 0; i < 4; ++i) kv[i] = XS[(64 + s0 + i) * 129 + d] * RN[64 + s0 + i] * EKD[s0 + i];
            u32x2 w; w.x = pack2(kv[0], kv[1]); w.y = pack2(kv[2], kv[3]);
            *(u32x2*)(kd + p4 * 4) = w;
        }
    }
    if (tid == 511) *(float*)(rec + 73728) = GC[63];
    __syncthreads();
    {
#pragma unroll
        for (int ci = 0; ci < 2; ++ci) {
            const int ct = wid * 2 + ci, c = ct * 16 + r;
            f32x4 X[4];
#pragma unroll
            for (int bi = 0; bi < 4; ++bi) {
                f32x4 z = {0.f, 0.f, 0.f, 0.f};
#pragma unroll
                for (int kk = 0; kk < 2; ++kk) {
                    if (2 * kk < bi) {
                        const f32x4 zero = {0.f, 0.f, 0.f, 0.f};
                        const bf16x8 Bop = pack_b(X[2 * kk], (2 * kk + 1 < bi) ? X[2 * kk + 1] : zero);
                        z = mfma16(*(const bf16x8*)(MP16 + (bi * 16 + r) * 72 + kk * 32 + q * 8), Bop, z);
                    }
                }
#pragma unroll
                for (int j = 0; j < 4; ++j) { const int t = bi * 16 + q * 4 + j;
                    const float rv = ct < 8 ? XS[(128 + t) * 129 + c] * BETA[t] : XS[(64 + t) * 129 + (c - 128)] * RN[64 + t] * BETA[t] * EGC[t];
                    z[j] = rv - z[j]; }
                const f32x4 zero = {0.f, 0.f, 0.f, 0.f};
                X[bi] = mfma16(*(const bf16x8*)(TP16 + (bi * 16 + r) * 40 + q * 8), pack_b(z, zero), zero);
            }
            if (ct < 8) { bf16_t* up = (bf16_t*)(rec + 57344);
#pragma unroll
                for (int bi = 0; bi < 4; ++bi) { u32x2 w; w.x = pack2(X[bi][0], X[bi][1]); w.y = pack2(X[bi][2], X[bi][3]); *(u32x2*)(up + ((ct * 4 + bi) * 64 + lane) * 4) = w; }
            } else { bf16_t* wp = (bf16_t*)rec; const int d = c - 128, pd = (d & ~31) + permpos(d & 31);
#pragma unroll
                for (int bi = 0; bi < 4; ++bi)
#pragma unroll
                    for (int j = 0; j < 4; ++j) wp[(bi * 16 + q * 4 + j) * 128 + pd] = f2bf(X[bi][j]); }
        }
    }
    __syncthreads();
}

constexpr int GD_HALF_LDS = 79872;
__device__ __forceinline__ void gd_m1c(unsigned char* lds, const Params& p, int l, int b, int h, int n) {
    const int tid = opaque_tid(), t8 = tid & 255, lane = tid & 63, w4 = (tid >> 6) & 3, r = lane & 15, q = lane >> 4;
    unsigned char* hl = lds + (tid >> 8) * GD_HALF_LDS;
    bf16_t* Q16 = (bf16_t*)hl; bf16_t* K16 = (bf16_t*)(hl + 18432); bf16_t* V16 = (bf16_t*)(hl + 36864);
    float* MMD = (float*)(hl + 55296);
    float* BETA = (float*)(hl + 59392); float* GC = BETA + 64; float* EGC = GC + 64; float* EKD = EGC + 64; float* RN = EKD + 64;
    bf16_t* MP16 = (bf16_t*)(hl + 60928); bf16_t* TP16 = (bf16_t*)(hl + 71168);
    bf16_t* proj = (bf16_t*)(p.ws + WS_PROJ); const float* gates = (const float*)(p.ws + WS_GATES);
    unsigned char* rec = p.ws + WS_GDREC + (size_t)((b * 4 + h) * 32 + n) * GDREC_BYTES;
    const int row0 = b * SEQ + n * 64;
    for (int i = t8; i < 1024; i += 256) *(u32x4*)(hl + 60928 + i * 16) = (u32x4){0u, 0u, 0u, 0u};
    for (int task = t8; task < 384; task += 256) {
        const int ts = task / 48, cg = task - ts * 48, sel = cg >> 4, ch8 = (cg & 15) * 8, t0 = ts * 8;
        const float* cw = p.gd_conv_w + (size_t)l * 4 * 1536 + sel * 512 + h * 128 + ch8;
        f32x4 wv[4][2];
#pragma unroll
        for (int k = 0; k < 4; ++k) { wv[k][0] = *(const f32x4*)(cw + k * 1536); wv[k][1] = *(const f32x4*)(cw + k * 1536 + 4); }
        const bf16_t* src = proj + (size_t)(row0 + t0 - 3) * NPROJ + COL_GDQ + sel * 512 + h * 128 + ch8;
        u32x4 xr[11];
#pragma unroll
        for (int i = 0; i < 11; ++i) { xr[i] = (u32x4){0u, 0u, 0u, 0u}; if (n > 0 || t0 - 3 + i >= 0) xr[i] = *(const u32x4*)(src + (size_t)i * NPROJ); }
        bf16_t* dst = (bf16_t*)(hl + sel * 18432) + t0 * 144 + ch8;
#pragma unroll
        for (int j = 0; j < 8; ++j) {
            float o[8];
#pragma unroll
            for (int e = 0; e < 8; ++e) {
                float a = 0.f;
#pragma unroll
                for (int k = 0; k < 4; ++k) { const unsigned w = xr[j + k][e >> 1]; a += wv[k][e >> 2][e & 3] * ((e & 1) ? bfhi(w) : bflo(w)); }
                o[e] = silu_(a);
            }
            u32x4 w; w.x = pack2(o[0], o[1]); w.y = pack2(o[2], o[3]); w.z = pack2(o[4], o[5]); w.w = pack2(o[6], o[7]);
            *(u32x4*)(dst + j * 144) = w;
        }
    }
    if (w4 == 3) {
        const int t = lane; const float* gp = gates + (size_t)(row0 + t) * 16;
        const float beta = sigmoid_(gp[12 + h]), g = -__expf(p.gd_a_log[l * 4 + h]) * softplus_(gp[8 + h] + p.gd_dt_bias[l * 4 + h]);
        const float gc = wave_incl_sum(g, lane), gl = __builtin_bit_cast(float, __builtin_amdgcn_readlane(__builtin_bit_cast(int, gc), 63));
        BETA[t] = beta; GC[t] = gc; EGC[t] = __expf(gc); EKD[t] = __expf(gl - gc);
    }
    __syncthreads();
#pragma unroll
    for (int s2 = 0; s2 < 2; ++s2) {
        const int t = t8 >> 2, part = t8 & 3; bf16_t* xr = (bf16_t*)(hl + s2 * 18432) + t * 144 + part * 32; u32x4 v[4]; float ss = 0.f;
#pragma unroll
        for (int i = 0; i < 4; ++i) { v[i] = *(const u32x4*)(xr + i * 8);
#pragma unroll
            for (int k = 0; k < 4; ++k) { const float a = bflo(v[i][k]), c = bfhi(v[i][k]); ss += a * a + c * c; } }
        ss = sum4_dpp(ss);
        float rn = rsqrtf(ss + EPS); if (s2 == 0) rn *= QSCALE;
        if (part == 0) RN[s2 * 64 + t] = rn;
#pragma unroll
        for (int i = 0; i < 4; ++i) { u32x4 w;
#pragma unroll
            for (int k = 0; k < 4; ++k) w[k] = pack2(bflo(v[i][k]) * rn, bfhi(v[i][k]) * rn);
            *(u32x4*)(xr + i * 8) = w; }
    }
    __syncthreads();
#pragma unroll
    for (int jj = 0; jj < 8; ++jj) {
        const int idx = w4 * 8 + jj, which = idx >> 4, tt = (idx >> 2) & 3, st = idx & 3;
        if (which == 0 && st > tt) continue;
        f32x4 acc = {0.f, 0.f, 0.f, 0.f};
        if (st <= tt) {
            const bf16_t* Ab = which ? Q16 : K16;
#pragma unroll
            for (int ks = 0; ks < 4; ++ks) acc = mfma16(*(const bf16x8*)(Ab + (tt * 16 + r) * 144 + ks * 32 + q * 8), *(const bf16x8*)(K16 + (st * 16 + r) * 144 + ks * 32 + q * 8), acc);
        }
        const int s = st * 16 + r; const float gcs = GC[s];
        bf16_t* aq = (bf16_t*)(rec + 49152);
#pragma unroll
        for (int j = 0; j < 4; ++j) {
            const int t = tt * 16 + q * 4 + j;
            if (which == 0) { const float mv = s < t ? BETA[t] * acc[j] * __expf(GC[t] - gcs) : 0.f; if (st == tt) MMD[(tt * 16 + q * 4 + j) * 16 + r] = mv; MP16[t * 80 + (st >> 1) * 32 + permpos(s & 31)] = f2bf(mv); }
            else aq[t * 64 + (st >> 1) * 32 + permpos(s & 31)] = f2bf(s <= t ? acc[j] * __expf(GC[t] - gcs) : 0.f);
        }
    }
    __syncthreads();
    if (t8 < 64) {
        const int bi = t8 >> 4, c = t8 & 15; float x[16];
#pragma unroll
        for (int t = 0; t < 16; ++t) x[t] = (t == c) ? 1.f : 0.f;
#pragma unroll
        for (int t = 1; t < 16; ++t) { float a = x[t];
#pragma unroll
            for (int s2 = 0; s2 < t; ++s2) a -= MMD[(bi * 16 + t) * 16 + s2] * x[s2];
            x[t] = a; }
#pragma unroll
        for (int t = 0; t < 16; ++t) TP16[(bi * 16 + t) * 48 + ((c >> 2) & 3) * 8 + (c & 3)] = f2bf(x[t]);
    }
#pragma unroll
    for (int k2 = 0; k2 < 2; ++k2) {
        const int task = t8 + 256 * k2, t = task >> 3, grp = task & 7; const bf16_t* xr = Q16 + t * 144 + grp * 16; const float sc = EGC[t];
        const u32x4 a0 = *(const u32x4*)xr, a1 = *(const u32x4*)(xr + 8);
        bf16_t* qd = (bf16_t*)(rec + 16384) + t * 128 + (grp >> 1) * 32;
#pragma unroll
        for (int rr = 0; rr < 4; ++rr) { const unsigned w0 = rr < 2 ? a0[(rr & 1) * 2] : a1[(rr & 1) * 2], w1 = rr < 2 ? a0[(rr & 1) * 2 + 1] : a1[(rr & 1) * 2 + 1];
            u32x2 w; w.x = pack2(bflo(w0) * sc, bfhi(w0) * sc); w.y = pack2(bflo(w1) * sc, bfhi(w1) * sc);
            *(u32x2*)(qd + (rr * 2 + (grp & 1)) * 4) = w; }
    }
    if (t8 >= 128) {
        const int d = t8 - 128; bf16_t* kd = (bf16_t*)(rec + 32768) + d * 64;
#pragma unroll
        for (int p4 = 0; p4 < 16; ++p4) {
            const int pp = (p4 * 4) & 31, s0 = ((p4 * 4) >> 5) * 32 + ((pp >> 2) & 1) * 16 + (pp >> 3) * 4;
            float kv[4];
#pragma unroll
            for (int i = 0; i < 4; ++i) kv[i] = bf2f(K16[(s0 + i) * 144 + d]) * EKD[s0 + i];
            u32x2 w; w.x = pack2(kv[0], kv[1]); w.y = pack2(kv[2], kv[3]);
            *(u32x2*)(kd + p4 * 4) = w;
        }
    }
    if (t8 == 255) *(float*)(rec + 73728) = GC[63];
    __syncthreads();
#pragma unroll
    for (int ci = 0; ci < 4; ++ci) {
        const int ct = w4 * 4 + ci, c = ct * 16 + r;
        f32x4 X[4];
#pragma unroll
        for (int bi = 0; bi < 4; ++bi) {
            f32x4 z = {0.f, 0.f, 0.f, 0.f};
#pragma unroll
            for (int kk = 0; kk < 2; ++kk) {
                if (2 * kk < bi) {
                    const f32x4 zero = {0.f, 0.f, 0.f, 0.f};
                    const bf16x8 Bop = pack_b(X[2 * kk], (2 * kk + 1 < bi) ? X[2 * kk + 1] : zero);
                    z = mfma16(*(const bf16x8*)(MP16 + (bi * 16 + r) * 80 + kk * 32 + q * 8), Bop, z);
                }
            }
#pragma unroll
            for (int j = 0; j < 4; ++j) { const int t = bi * 16 + q * 4 + j;
                const float rv = ct < 8 ? bf2f(V16[t * 144 + c]) * BETA[t] : bf2f(K16[t * 144 + (c - 128)]) * BETA[t] * EGC[t];
                z[j] = rv - z[j]; }
            const f32x4 zero = {0.f, 0.f, 0.f, 0.f};
            X[bi] = mfma16(*(const bf16x8*)(TP16 + (bi * 16 + r) * 48 + q * 8), pack_b(z, zero), zero);
        }
        if (ct < 8) { bf16_t* up = (bf16_t*)(rec + 57344);
#pragma unroll
            for (int bi = 0; bi < 4; ++bi) { u32x2 w; w.x = pack2(X[bi][0], X[bi][1]); w.y = pack2(X[bi][2], X[bi][3]); *(u32x2*)(up + ((ct * 4 + bi) * 64 + lane) * 4) = w; }
        } else { bf16_t* wp = (bf16_t*)rec; const int d = c - 128, pd = (d & ~31) + permpos(d & 31);
#pragma unroll
            for (int bi = 0; bi < 4; ++bi)
#pragma unroll
                for (int j = 0; j < 4; ++j) wp[(bi * 16 + q * 4 + j) * 128 + pd] = f2bf(X[bi][j]); }
    }
    __syncthreads();
}

__device__ __forceinline__ void gd_m2(unsigned char* lds, const Params& p, int l, int b, int h) {
    const int tid = opaque_tid(), lane = tid & 63, wid = __builtin_amdgcn_readfirstlane(tid >> 6), r = lane & 15, q = lane >> 4;
    bf16_t* OB = (bf16_t*)(lds + 122880);
    float* NWT = (float*)(lds + 122880 + 32768);
    bf16_t* proj = (bf16_t*)(p.ws + WS_PROJ);
    const unsigned char* rec0 = p.ws + WS_GDREC + (size_t)((b * 4 + h) * 32) * GDREC_BYTES;
    const int erow = tid >> 3, eseg = tid & 7;
    unsigned soff[7], doff[7];
#pragma unroll
    for (int i = 0; i < 7; ++i) { const int ci = tid + 512 * i;
        if (i < 2) { soff[i] = ci * 16; doff[i] = (ci >> 4) * 288 + (ci & 15) * 16; }
        else if (i < 4) { const int c2 = ci - 1024; soff[i] = 16384 + c2 * 16; doff[i] = 18432 + (c2 >> 4) * 288 + (c2 & 15) * 16; }
        else if (i < 6) { const int c2 = ci - 2048, rw = c2 >> 3; soff[i] = 32768 + c2 * 16; doff[i] = 36864 + rw * 128 + (((c2 & 7) ^ ((rw >> 1) & 7)) * 16); }
        else { const int c2 = ci - 3072, rw = c2 >> 3; soff[i] = 49152 + c2 * 16; doff[i] = 53248 + rw * 128 + (((c2 & 7) ^ ((rw >> 1) & 7)) * 16); } }
    u32x4 st[7];
#pragma unroll
    for (int i = 0; i < 7; ++i) st[i] = *(const u32x4*)(rec0 + soff[i]);
#pragma unroll
    for (int i = 0; i < 7; ++i) *(u32x4*)(lds + doff[i]) = st[i];
    if (tid < 128) NWT[tid] = p.gd_norm_w[l * 128 + tid];
    f32x4 S[8];
#pragma unroll
    for (int d = 0; d < 8; ++d) S[d] = (f32x4){0.f, 0.f, 0.f, 0.f};
    u32x2 un[4]; float egn;
    {
        const unsigned char* up = rec0 + 57344 + wid * 2048;
#pragma unroll
        for (int tt = 0; tt < 4; ++tt) un[tt] = *(const u32x2*)(up + (unsigned)(lane * 8) + tt * 512);
        egn = *(const float*)(rec0 + 73728);
    }
    __syncthreads();
    if (wid >= 4) __builtin_amdgcn_s_setprio(1);
    for (int n = 0; n <= 32; ++n) {
        const int nn = opaque_s(n);
        const unsigned char* cur = lds + (n & 1) * 61440; unsigned char* nxt = lds + ((n + 1) & 1) * 61440;
        const int swz = (r >> 1) & 7;
        const unsigned char* rec = rec0 + (size_t)nn * GDREC_BYTES;
        const unsigned eo = (unsigned)(erow * NPROJ + eseg * 16) * 2u;
        u32x4 zz[2];
        if (n >= 1) {
            const unsigned char* zb = (const unsigned char*)(proj + (size_t)(b * SEQ + (nn - 1) * 64) * NPROJ + COL_GDZ + h * 128);
            zz[0] = *(const u32x4*)(zb + eo); zz[1] = *(const u32x4*)(zb + eo + 16);
        }
        u32x2 uu[4]; const float eg = __expf(egn);
#pragma unroll
        for (int tt = 0; tt < 4; ++tt) uu[tt] = un[tt];
        if (n + 1 < 32) {
#pragma unroll
            for (int i = 0; i < 7; ++i) st[i] = *(const u32x4*)(rec + GDREC_BYTES + soff[i]);
            const unsigned char* up = rec + GDREC_BYTES + 57344 + wid * 2048;
#pragma unroll
            for (int tt = 0; tt < 4; ++tt) un[tt] = *(const u32x2*)(up + (unsigned)(lane * 8) + tt * 512);
            egn = *(const float*)(rec + GDREC_BYTES + 73728);
        }
        __builtin_amdgcn_sched_barrier(0);
        if (n < 32) {
            f32x4 av[4], o[4];
#pragma unroll
            for (int tt = 0; tt < 4; ++tt) { av[tt] = (f32x4){0.f, 0.f, 0.f, 0.f}; o[tt] = (f32x4){0.f, 0.f, 0.f, 0.f}; }
            bf16x8 F0[8], F1[8];
#define GD_LOAD_A(F, ks) do { _Pragma("unroll") for (int tt = 0; tt < 4; ++tt) { F[tt] = *(const bf16x8*)(cur + (tt * 16 + r) * 288 + ((ks) * 32 + q * 8) * 2); \
                F[4 + tt] = *(const bf16x8*)(cur + 18432 + (tt * 16 + r) * 288 + ((ks) * 32 + q * 8) * 2); } } while (0)
#define GD_MMA_A(F, ks) do { const bf16x8 Sb = pack_b(S[2 * (ks)], S[2 * (ks) + 1]); _Pragma("unroll") for (int tt = 0; tt < 4; ++tt) { av[tt] = mfma16(F[tt], Sb, av[tt]); o[tt] = mfma16(F[4 + tt], Sb, o[tt]); } } while (0)
            GD_LOAD_A(F0, 0); __builtin_amdgcn_sched_barrier(0);
            GD_LOAD_A(F1, 1); __builtin_amdgcn_sched_barrier(0); GD_MMA_A(F0, 0); __builtin_amdgcn_sched_barrier(0);
            GD_LOAD_A(F0, 2); __builtin_amdgcn_sched_barrier(0); GD_MMA_A(F1, 1); __builtin_amdgcn_sched_barrier(0);
            GD_LOAD_A(F1, 3); __builtin_amdgcn_sched_barrier(0); GD_MMA_A(F0, 2); __builtin_amdgcn_sched_barrier(0);
#pragma unroll
            for (int tt = 0; tt < 4; ++tt)
#pragma unroll
                for (int k2 = 0; k2 < 2; ++k2) F0[tt * 2 + k2] = *(const bf16x8*)(cur + 53248 + (tt * 16 + r) * 128 + (((k2 * 4 + q) ^ swz) * 16));
            __builtin_amdgcn_sched_barrier(0); GD_MMA_A(F1, 3); __builtin_amdgcn_sched_barrier(0);
#pragma unroll
            for (int tt = 0; tt < 4; ++tt) { const u32x2 w = uu[tt];
                av[tt][0] = bflo(w.x) - av[tt][0]; av[tt][1] = bfhi(w.x) - av[tt][1]; av[tt][2] = bflo(w.y) - av[tt][2]; av[tt][3] = bfhi(w.y) - av[tt][3]; }
            bf16x8 Vb[2];
#pragma unroll
            for (int k2 = 0; k2 < 2; ++k2) Vb[k2] = pack_b(av[2 * k2], av[2 * k2 + 1]);
#pragma unroll
            for (int d = 0; d < 4; ++d)
#pragma unroll
                for (int k2 = 0; k2 < 2; ++k2) F1[d * 2 + k2] = *(const bf16x8*)(cur + 36864 + (d * 16 + r) * 128 + (((k2 * 4 + q) ^ swz) * 16));
            __builtin_amdgcn_sched_barrier(0);
#pragma unroll
            for (int tt = 0; tt < 4; ++tt)
#pragma unroll
                for (int k2 = 0; k2 < 2; ++k2) o[tt] = mfma16(F0[tt * 2 + k2], Vb[k2], o[tt]);
            __builtin_amdgcn_sched_barrier(0);
#pragma unroll
            for (int d = 0; d < 4; ++d)
#pragma unroll
                for (int k2 = 0; k2 < 2; ++k2) F0[d * 2 + k2] = *(const bf16x8*)(cur + 36864 + ((4 + d) * 16 + r) * 128 + (((k2 * 4 + q) ^ swz) * 16));
            __builtin_amdgcn_sched_barrier(0);
#pragma unroll
            for (int d = 0; d < 4; ++d) { S[d] *= eg;
#pragma unroll
                for (int k2 = 0; k2 < 2; ++k2) S[d] = mfma16(F1[d * 2 + k2], Vb[k2], S[d]); }
            __builtin_amdgcn_sched_barrier(0);
#pragma unroll
            for (int d = 0; d < 4; ++d) { S[4 + d] *= eg;
#pragma unroll
                for (int k2 = 0; k2 < 2; ++k2) S[4 + d] = mfma16(F0[d * 2 + k2], Vb[k2], S[4 + d]); }
#undef GD_LOAD_A
#undef GD_MMA_A
            bf16_t* ob = OB + (n & 1) * 8192;
#pragma unroll
            for (int tt = 0; tt < 4; ++tt)
#pragma unroll
                for (int j = 0; j < 4; ++j) ob[(tt * 16 + q * 4 + j) * 128 + wid * 16 + r] = f2bf(o[tt][j]);
        }
        __builtin_amdgcn_sched_barrier(0);
        if (n >= 1) {
            const bf16_t* ob = OB + ((n - 1) & 1) * 8192 + erow * 128 + eseg * 16;
            u32x4 ov[2]; float ss = 0.f;
#pragma unroll
            for (int i = 0; i < 2; ++i) { ov[i] = *(const u32x4*)(ob + i * 8);
#pragma unroll
                for (int k = 0; k < 4; ++k) { const float a = bflo(ov[i][k]), c = bfhi(ov[i][k]); ss += a * a + c * c; } }
            ss = sum8_dpp(ss);
            const float rs = rsqrtf(ss * (1.0f / 128.0f) + EPS);
            unsigned char* yb = (unsigned char*)(proj + (size_t)(b * SEQ + (nn - 1) * 64) * NPROJ + YOFF + 1024 + h * 128);
#pragma unroll
            for (int i = 0; i < 2; ++i) { u32x4 w;
#pragma unroll
                for (int k = 0; k < 4; ++k) { const int e = eseg * 16 + i * 8 + k * 2;
                    w[k] = pack2(bflo(ov[i][k]) * rs * NWT[e] * silu_(bflo(zz[i][k])), bfhi(ov[i][k]) * rs * NWT[e + 1] * silu_(bfhi(zz[i][k]))); }
                *(u32x4*)(yb + eo + i * 16) = w; }
        }
        __builtin_amdgcn_sched_barrier(0);
        if (n + 1 < 32) {
#pragma unroll
            for (int i = 0; i < 7; ++i) *(u32x4*)(nxt + doff[i]) = st[i];
        }
        __syncthreads();
    }
    __builtin_amdgcn_s_setprio(0);
}

__device__ __forceinline__ void ml_m2(unsigned char* lds, const Params& p, int l, int b, int h) {
    const int tid = opaque_tid(), lane = tid & 63, wid = __builtin_amdgcn_readfirstlane(tid >> 6), r = lane & 15, q = lane >> 4;
    constexpr int BUFB = 18432 + 2048;
    float* NV = (float*)(lds + 2 * BUFB);
    float* NWT = NV + 256;
    bf16_t* OB = (bf16_t*)(lds + 2 * BUFB + 2048);
    float* ET = (float*)(lds + 2 * BUFB + 2048 + 32768);
    bf16_t* proj = (bf16_t*)(p.ws + WS_PROJ);
    const unsigned char* rec0 = p.ws + WS_MLREC + (size_t)((b * 4 + h) * 32) * MLREC_BYTES;
    const int erow = tid >> 3, eseg = tid & 7;
    unsigned qsrc[4], qdst[4];
#pragma unroll
    for (int i = 0; i < 4; ++i) { const int ci = tid + 512 * i, rw = ci >> 5, c8 = ci & 31, grp = c8 >> 3, n4 = c8 & 7, p4 = (n4 & 3) * 2 + (n4 >> 2);
        qsrc[i] = (unsigned)(rw * NPROJ + COL_MLQ + h * 128 + c8 * 4) * 2u; qdst[i] = rw * 288 + (grp * 8 + p4) * 8; }
    const unsigned dco = (unsigned)(h * 128 + (lane < 32 ? COL_MLK + lane * 4 : COL_MLV + (lane - 32) * 4)) * 2u;
    u32x2 sq[4]; u32x4 ssc = {0u, 0u, 0u, 0u};
    u32x2 dCn[8], inn[4];
    {
        const unsigned char* pb = (const unsigned char*)(proj + (size_t)(b * SEQ) * NPROJ);
#pragma unroll
        for (int i = 0; i < 4; ++i) sq[i] = *(const u32x2*)(pb + qsrc[i]);
        if (tid < 84) ssc = *(const u32x4*)(rec0 + 32768 + tid * 16);
#pragma unroll
        for (int d = 0; d < 8; ++d) dCn[d] = *(const u32x2*)(pb + (size_t)(wid * 8 + d) * (NPROJ * 2) + dco);
#pragma unroll
        for (int tt = 0; tt < 4; ++tt) inn[tt] = *(const u32x2*)(rec0 + (unsigned)(((wid * 4 + tt) * 64 + lane) * 8));
#pragma unroll
        for (int i = 0; i < 4; ++i) *(u32x2*)(lds + qdst[i]) = sq[i];
        if (tid < 84) *(u32x4*)(lds + 18432 + tid * 16) = ssc;
        if (tid < 256) NV[tid] = 0.f;
        if (tid < 128) NWT[tid] = p.ml_norm_w[l * 512 + h * 128 + tid];
    }
    f32x4 C[8];
#pragma unroll
    for (int d = 0; d < 8; ++d) C[d] = (f32x4){0.f, 0.f, 0.f, 0.f};
    float mst = 0.f, inv_prev = 0.f;
    __syncthreads();
    if (eseg == 0) { const float* sc0 = (const float*)(lds + 18432); const float mloc = sc0[erow], minter = sc0[64 + erow], mt = fmaxf(minter, mloc);
        *(f32x4*)(ET + erow * 4) = (f32x4){__expf(mloc - mt), __expf(minter - mt) * QSCALE, __expf(-mt), 0.f}; }
    __syncthreads();
    if (wid >= 4) __builtin_amdgcn_s_setprio(1);
    for (int n = 0; n <= 32; ++n) {
        const int nn = opaque_s(n);
        const unsigned char* cur = lds + (n & 1) * BUFB; unsigned char* nxt = lds + ((n + 1) & 1) * BUFB;
        const float* sc = (const float*)(cur + 18432);
        const unsigned char* rec = rec0 + (size_t)nn * MLREC_BYTES;
        const unsigned char* pb = (const unsigned char*)(proj + (size_t)(b * SEQ + nn * 64) * NPROJ);
        const unsigned eo = (unsigned)(erow * NPROJ + eseg * 16) * 2u;
        u32x4 gg[2];
        if (n >= 1) {
            const unsigned char* gb = rec - MLREC_BYTES + 16384 + (erow * 128 + eseg * 16) * 2;
            gg[0] = *(const u32x4*)gb; gg[1] = *(const u32x4*)(gb + 16);
        }
        u32x2 dC[8], inum[4]; float nml = 0.f, nbc = 0.f;
#pragma unroll
        for (int d = 0; d < 8; ++d) dC[d] = dCn[d];
#pragma unroll
        for (int tt = 0; tt < 4; ++tt) inum[tt] = inn[tt];
        if (n + 1 < 32) {
            const unsigned char* pn = pb + (size_t)64 * NPROJ * 2;
#pragma unroll
            for (int i = 0; i < 4; ++i) sq[i] = *(const u32x2*)(pn + qsrc[i]);
            if (tid < 84) ssc = *(const u32x4*)(rec + MLREC_BYTES + 32768 + tid * 16);
            nml = *(const float*)(rec + MLREC_BYTES + 32768 + erow * 4); nbc = *(const float*)(rec + MLREC_BYTES + 32768 + 256 + erow * 4);
#pragma unroll
            for (int d = 0; d < 8; ++d) dCn[d] = *(const u32x2*)(pn + (size_t)(wid * 8 + d) * (NPROJ * 2) + dco);
#pragma unroll
            for (int tt = 0; tt < 4; ++tt) inn[tt] = *(const u32x2*)(rec + MLREC_BYTES + (unsigned)(((wid * 4 + tt) * 64 + lane) * 8));
        }
        float inv_cur = 0.f;
        __builtin_amdgcn_sched_barrier(0);
        if (n < 32) {
            const float g = sc[320], mw = sc[321];
            const float mnew = fmaxf(g + mst, mw), alpha = __expf(g + mst - mnew), bet = __expf(mw - mnew);
            f32x4 aq[4];
#pragma unroll
            for (int tt = 0; tt < 4; ++tt) aq[tt] = (f32x4){0.f, 0.f, 0.f, 0.f};
#pragma unroll
            for (int kh = 0; kh < 2; ++kh) {
                bf16x8 FQ[8];
#pragma unroll
                for (int k2 = 0; k2 < 2; ++k2)
#pragma unroll
                    for (int tt = 0; tt < 4; ++tt) FQ[k2 * 4 + tt] = *(const bf16x8*)(cur + (tt * 16 + r) * 288 + ((kh * 2 + k2) * 32 + q * 8) * 2);
                __builtin_amdgcn_sched_barrier(0);
#pragma unroll
                for (int k2 = 0; k2 < 2; ++k2) {
                    const int ks = kh * 2 + k2; const bf16x8 Cb = pack_b(C[2 * ks], C[2 * ks + 1]);
#pragma unroll
                    for (int tt = 0; tt < 4; ++tt) aq[tt] = mfma16(FQ[k2 * 4 + tt], Cb, aq[tt]);
                }
                __builtin_amdgcn_sched_barrier(0);
            }
            bf16_t* ob = OB + (n & 1) * 8192;
#pragma unroll
            for (int tt = 0; tt < 4; ++tt) { const u32x2 w = inum[tt];
#pragma unroll
                for (int j = 0; j < 4; ++j) {
                    const int t = tt * 16 + q * 4 + j;
                    const f32x2v et = *(const f32x2v*)(ET + ((n & 1) * 64 + t) * 4); const float e1 = et.x, e2 = et.y;
                    const unsigned ww = j < 2 ? w.x : w.y; const float iv = (j & 1) ? bfhi(ww) : bflo(ww);
                    ob[t * 128 + wid * 16 + r] = f2bf(e1 * iv + e2 * aq[tt][j]);
                } }
            {
                const float* nv = NV + (n & 1) * 128 + eseg * 16;
                const u32x4 q0 = *(const u32x4*)(cur + erow * 288 + eseg * 32), q1 = *(const u32x4*)(cur + erow * 288 + eseg * 32 + 16);
                float sdot = 0.f;
#pragma unroll
                for (int k = 0; k < 4; ++k) { sdot += bflo(q0[k]) * nv[2 * k] + bfhi(q0[k]) * nv[2 * k + 1]; sdot += bflo(q1[k]) * nv[8 + 2 * k] + bfhi(q1[k]) * nv[8 + 2 * k + 1]; }
                sdot = sum8_dpp(sdot);
                const f32x4 et = *(const f32x4*)(ET + ((n & 1) * 64 + erow) * 4);
                const float den = et[0] * sc[128 + erow] + et[1] * sdot;
                inv_cur = 1.0f / fmaxf(fabsf(den), et[2]);
                if (eseg == 0 && n + 1 < 32) {
                    const float minter = nbc + mnew, mt = fmaxf(minter, nml);
                    *(f32x4*)(ET + (((n + 1) & 1) * 64 + erow) * 4) = (f32x4){__expf(nml - mt), __expf(minter - mt) * QSCALE, __expf(-mt), 0.f};
                }
            }
#pragma unroll
            for (int d = 0; d < 8; ++d) { const u32x2 w = dC[d];
                C[d][0] = alpha * C[d][0] + bet * bflo(w.x); C[d][1] = alpha * C[d][1] + bet * bfhi(w.x);
                C[d][2] = alpha * C[d][2] + bet * bflo(w.y); C[d][3] = alpha * C[d][3] + bet * bfhi(w.y); }
            if (tid < 128) { const int pos = (tid & ~31) + permpos(tid & 31); NV[((n + 1) & 1) * 128 + pos] = alpha * NV[(n & 1) * 128 + pos] + bet * sc[192 + tid]; }
            mst = mnew;
        }
        __builtin_amdgcn_sched_barrier(0);
        if (n >= 1) {
            const bf16_t* ob = OB + ((n - 1) & 1) * 8192 + erow * 128 + eseg * 16;
            u32x4 ov[2]; float ss = 0.f; float hh[16];
#pragma unroll
            for (int i = 0; i < 2; ++i) { ov[i] = *(const u32x4*)(ob + i * 8);
#pragma unroll
                for (int k = 0; k < 4; ++k) { const float a = bflo(ov[i][k]) * inv_prev, c = bfhi(ov[i][k]) * inv_prev; hh[i * 8 + 2 * k] = a; hh[i * 8 + 2 * k + 1] = c; ss += a * a + c * c; } }
            ss = sum8_dpp(ss);
            const float rs = rsqrtf(ss * (1.0f / 128.0f) + EPS);
            unsigned char* yb = (unsigned char*)(proj + (size_t)(b * SEQ + (nn - 1) * 64) * NPROJ + YOFF + 512 + h * 128);
#pragma unroll
            for (int i = 0; i < 2; ++i) { u32x4 w;
#pragma unroll
                for (int k = 0; k < 4; ++k) { const int e = eseg * 16 + i * 8 + k * 2;
                    w[k] = pack2(hh[i * 8 + 2 * k] * rs * NWT[e] * bflo(gg[i][k]), hh[i * 8 + 2 * k + 1] * rs * NWT[e + 1] * bfhi(gg[i][k])); }
                *(u32x4*)(yb + eo + i * 16) = w; }
        }
        inv_prev = inv_cur;
        __builtin_amdgcn_sched_barrier(0);
        if (n + 1 < 32) {
#pragma unroll
            for (int i = 0; i < 4; ++i) *(u32x2*)(nxt + qdst[i]) = sq[i];
            if (tid < 84) *(u32x4*)(nxt + 18432 + tid * 16) = ssc;
        }
        __syncthreads();
    }
    __builtin_amdgcn_s_setprio(0);
}

#define XB_TMO      128
#define XB_XCNT(j)  (256  + 64 * (j))
#define XB_XSUB(j)  (1280 + 64 * (j))
#define XB_XGEN(j)  (2304 + 64 * (j))
#define XB_TOP      3328
#define XB_TOPGEN   3392
#define XCD_BAR_WORDS 3456
#define XB_SPIN_CAP (1u << 18)

__device__ __forceinline__ unsigned xb_ld(unsigned* p)              { return __hip_atomic_load(p, __ATOMIC_RELAXED, __HIP_MEMORY_SCOPE_AGENT); }
__device__ __forceinline__ unsigned xb_add(unsigned* p, unsigned v) { return __hip_atomic_fetch_add(p, v, __ATOMIC_RELAXED, __HIP_MEMORY_SCOPE_AGENT); }
__device__ __forceinline__ unsigned xb_xcc_id() { return (unsigned)__builtin_amdgcn_s_getreg((3 << 11) | 20) & 0xFu; }
#define XB_SPIN(cond, bar) do { unsigned _sp = 0; while (cond) { __builtin_amdgcn_s_sleep(1); \
    if ((++_sp & 255u) == 0u) { if (xb_ld(&(bar)[XB_TMO])) break; if (_sp > XB_SPIN_CAP) { atomicAdd(&(bar)[XB_TMO], 1u); break; } } } } while (0)

struct XcdBarrier {
    unsigned* bar; unsigned x;
    volatile LAS unsigned* st;
};

__device__ __forceinline__ XcdBarrier xcd_barrier_post(unsigned* bar, volatile LAS unsigned* st) {
    XcdBarrier b; b.bar = bar; b.x = xb_xcc_id(); b.st = st;
    if (threadIdx.x == 0) (void)xb_add(&bar[XB_XCNT(b.x)], 1u);
    return b;
}
__device__ __forceinline__ void xcd_barrier_complete(unsigned* bar, unsigned x, unsigned& nloc, unsigned& nx) {
    const unsigned G = gridDim.x * gridDim.y * gridDim.z;
    unsigned sum, cnt, mine, sp = 0u;
    for (;;) {
        sum = 0u; cnt = 0u; mine = 0u;
#pragma unroll
        for (unsigned j = 0; j < 16; ++j) { const unsigned c = xb_ld(&bar[XB_XCNT(j)]); sum += c; cnt += (c > 0u) ? 1u : 0u; mine = (j == x) ? c : mine; }
        if (sum == G) break;
        __builtin_amdgcn_s_sleep(1);
        if ((++sp & 255u) == 0u) { if (xb_ld(&bar[XB_TMO])) break; if (sp > XB_SPIN_CAP) { atomicAdd(&bar[XB_TMO], 1u); break; } }
    }
    nloc = mine > 0u ? mine : 1u; nx = cnt > 0u ? cnt : 1u;
}

__device__ __forceinline__ void xcd_barrier(const XcdBarrier& b) {
    asm volatile("s_waitcnt vmcnt(0)" ::: "memory");
    __syncthreads();
    if (threadIdx.x == 0) {
        unsigned* bar = b.bar;
        __builtin_amdgcn_s_waitcnt(0);
        unsigned nloc = b.st[0], nx = b.st[1];
        if (nloc == 0u) { xcd_barrier_complete(bar, b.x, nloc, nx); b.st[0] = nloc; b.st[1] = nx; }
        const unsigned old = xb_add(&bar[XB_XSUB(b.x)], 1u);
        const unsigned gen = old / nloc;
        if (old + 1u == (gen + 1u) * nloc) {
            __builtin_amdgcn_fence(__ATOMIC_RELEASE, "agent");
            asm volatile("s_waitcnt vmcnt(0)" ::: "memory");
            const unsigned og = xb_add(&bar[XB_TOP], 1u);
            const unsigned tg = og / nx;
            if (og + 1u == (tg + 1u) * nx) xb_add(&bar[XB_TOPGEN], 1u);
            else XB_SPIN(xb_ld(&bar[XB_TOPGEN]) == tg, bar);
            __builtin_amdgcn_fence(__ATOMIC_ACQUIRE, "agent");
            xb_add(&bar[XB_XGEN(b.x)], 1u);
            asm volatile("s_waitcnt vmcnt(0)" ::: "memory");
        } else {
            XB_SPIN(xb_ld(&bar[XB_XGEN(b.x)]) == gen, bar);
            __builtin_amdgcn_fence(__ATOMIC_ACQUIRE, "agent");
            asm volatile("s_waitcnt vmcnt(0)" ::: "memory");
        }
    }
    __syncthreads();
}


#ifndef N_LAUNCH_MODE
#define N_LAUNCH_MODE 1
#endif
#ifndef PROBE_REPEAT
#define PROBE_REPEAT -1
#endif
#ifndef PROBE_SUB
#define PROBE_SUB 0
#endif
#define REP(k) ((k) == PROBE_REPEAT ? 2 : 1)
__global__ void __launch_bounds__(512, 2) hymba_mega(Params p, int ph_lo, int ph_hi) {
    extern __shared__ __attribute__((aligned(16))) unsigned char lds[];
    cg::grid_group grid = cg::this_grid();
    const int G = gridDim.x, bid = blockIdx.x;
    volatile LAS unsigned* xst = (volatile LAS unsigned*)((LAS unsigned char*)lds + (LDS_BYTES - 16));
    if (threadIdx.x < 2) xst[threadIdx.x] = 0u;
    __syncthreads();
    const XcdBarrier xb = xcd_barrier_post((unsigned*)(p.ws + WS_BAR), xst);
    int ph = 0;
#if N_LAUNCH_MODE == 1
#define PHASE_BEGIN {
#define PHASE_END if (ph + 1 < 18) { if (ph == 0) grid.sync(); else xcd_barrier(xb); } } ++ph;
#else
#define PHASE_BEGIN if (ph >= ph_lo && ph < ph_hi) {
#define PHASE_END if (ph + 1 < ph_hi) grid.sync(); } ++ph;
#endif
    PHASE_BEGIN
        for (int rep = 0; rep < REP(0); ++rep) { if (rep) grid.sync();
        for (int u = bid; u < NU_P0; u += G) p0_unit(lds, p, u); }
    PHASE_END
    for (int l = 0; l < DEPTH; ++l) {
        PHASE_BEGIN
            for (int rep = 0; rep < REP(1); ++rep) { if (rep) grid.sync();
            pg8::Gemm g{(const bf16_t*)(p.ws + WS_XB), (const bf16_t*)(p.ws + WS_BTIN), NTOK, NPAD, DM, DM};
            pg8::StaticOrder S; S.init(NTOK, NPAD, G, opaque_s(bid));
            LAS float* rtab = (LAS float*)((LAS unsigned char*)lds + 131072);
            {
                const float* ssq = (const float*)(p.ws + WS_SSQ); pg8::Unit uu;
                for (int i = 0; i < 8 && S.next(i, uu); ++i) {
                    const int tq = opaque_tid(), rl = tq >> 1, hf = tq & 1; const f32x4* sp = (const f32x4*)(ssq + (size_t)(uu.pm * 256 + rl) * 16 + hf * 8);
                    const f32x4 s0 = sp[0], s1 = sp[1]; float ss = ((s0[0] + s0[1]) + (s0[2] + s0[3])) + ((s1[0] + s1[1]) + (s1[2] + s1[3]));
                    ss += __shfl_xor(ss, 1);
                    if (hf == 0) rtab[i * 256 + rl] = rsqrtf(ss * (1.0f / 1024.0f) + EPS);
                }
                __syncthreads();
            }
            EpiIn E{(bf16_t*)(p.ws + WS_PROJ), (float*)(p.ws + WS_GATES), rtab, 0};
            pg8::gemm_phase<EpiIn>((LAS unsigned char*)lds, g, S, E); }
        PHASE_END
        PHASE_BEGIN
            for (int rep = 0; rep < REP(2); ++rep) { if (rep) grid.sync();
            for (int j = bid; j < 512; j += G) { const int u = 2 * j + (opaque_tid() >> 8); gd_m1c(lds, p, l, u >> 7, (u >> 5) & 3, u & 31); }
            for (int j = bid; j < 512; j += G) { const int v = 2 * j + (opaque_tid() >> 8); ml_m1c(lds, p, l, v >> 7, (v >> 5) & 3, v & 31); }
            for (int u = 2048 + bid; u < 2048 + 256; u += G) {
                { const int v = u - 2048; if (rep == 0 || PROBE_SUB == 0 || PROBE_SUB == 2) rg_unit2(lds, p, l, v >> 5, v & 31, 0); }
            } }
        PHASE_END
        PHASE_BEGIN
            for (int rep = 0; rep < REP(3); ++rep) { if (rep) grid.sync();
            for (int u = bid; u < 64; u += G) { if (u < 32) { if (rep == 0 || PROBE_SUB == 0 || PROBE_SUB == 1) gd_m2(lds, p, l, u >> 2, u & 3); }
                else { if (rep == 0 || PROBE_SUB == 0 || PROBE_SUB == 2) ml_m2(lds, p, l, (u - 32) >> 2, (u - 32) & 3); } }
            const int nb2 = G > 64 ? G - 64 : G, b2 = G > 64 ? bid - 64 : bid;
            const int ncv = l + 1 < DEPTH ? NU_BTIN : 0;
            if (b2 >= 0 && (rep == 0 || PROBE_SUB == 0 || PROBE_SUB == 3)) for (int u = b2; u < 256 + ncv; u += nb2) {
                if (u < 256) rg_unit2(lds, p, l, u >> 5, u & 31, 1);
                else cvt_btin_unit(lds, p, l + 1, u - 256);
            } }
        PHASE_END
        PHASE_BEGIN
            for (int rep = 0; rep < (l == 0 ? REP(4) : 1); ++rep) { if (rep) grid.sync();
            pg8::Gemm g{(const bf16_t*)(p.ws + WS_PROJ) + YOFF, (const bf16_t*)(p.ws + WS_BTOUT) + (size_t)l * DM * DMIX, NTOK, DM, DMIX, NPROJ};
            pg8::StaticOrder S; S.init(NTOK, DM, G, opaque_s(bid));
            EpiOut E{p.out, (bf16_t*)(p.ws + WS_XB), (float*)(p.ws + WS_SSQ), l == DEPTH - 1 ? 1 : 0};
            pg8::gemm_phase<EpiOut>((LAS unsigned char*)lds, g, S, E); }
        PHASE_END
    }
    PHASE_BEGIN
        const int tid = opaque_tid(), lane = tid & 63, wid = tid >> 6;
        const float* ssq = (const float*)(p.ws + WS_SSQ);
        for (int row = bid * 8 + wid; row < NTOK; row += G * 8) {
            float s = lane < 16 ? ssq[(size_t)row * 16 + lane] : 0.f; s = wave_sum(s);
            const float rr = rsqrtf(s * (1.0f / 1024.0f) + EPS);
            float* xr = p.out + (size_t)row * DM;
#pragma unroll
            for (int i = 0; i < 4; ++i) { const int c = i * 256 + lane * 4; f32x4 v = *(const f32x4*)(xr + c); const f32x4 w = *(const f32x4*)(p.final_norm_w + c);
                v[0] = v[0] * rr * w[0]; v[1] = v[1] * rr * w[1]; v[2] = v[2] * rr * w[2]; v[3] = v[3] * rr * w[3]; *(f32x4*)(xr + c) = v; }
        }
    PHASE_END
}

extern "C" void kernel_launch(void* const* d_in, const int* in_sizes, int n_in, void* d_out, int out_size, void* d_ws, size_t ws_size, hipStream_t stream) {
    static int grid = 0;
    if (grid == 0) {
        if (ws_size < WS_END) { fprintf(stderr, "kernel_launch: workspace too small (%zu < %zu)\n", ws_size, (size_t)WS_END); grid = -1; return; }
        int dev = 0, cus = 0, per_cu = 0;
        hipGetDevice(&dev);
        hipDeviceGetAttribute(&cus, hipDeviceAttributeMultiprocessorCount, dev);
        hipFuncSetAttribute((const void*)hymba_mega, hipFuncAttributeMaxDynamicSharedMemorySize, LDS_BYTES);
        hipOccupancyMaxActiveBlocksPerMultiprocessor(&per_cu, (const void*)hymba_mega, 512, LDS_BYTES);
        if (per_cu < 1) { fprintf(stderr, "kernel_launch: occupancy query says %d blocks per CU\n", per_cu); per_cu = 1; }
        if (per_cu > 1) per_cu = 1;
        grid = cus * per_cu;
    }
    if (grid < 0) return;
    Params p{};
    p.x = (const float*)d_in[0]; p.norm_w = (const float*)d_in[1]; p.w_in = (const float*)d_in[2]; p.rg_conv_w = (const float*)d_in[3]; p.rg_conv_b = (const float*)d_in[4];
    p.rg_gate_w = (const float*)d_in[5]; p.rg_gate_b = (const float*)d_in[6]; p.rg_lambda = (const float*)d_in[7]; p.ml_gate_b = (const float*)d_in[8]; p.ml_norm_w = (const float*)d_in[9];
    p.gd_conv_w = (const float*)d_in[10]; p.gd_a_log = (const float*)d_in[11]; p.gd_dt_bias = (const float*)d_in[12]; p.gd_norm_w = (const float*)d_in[13]; p.w_out = (const float*)d_in[14];
    p.final_norm_w = (const float*)d_in[15]; p.out = (float*)d_out; p.ws = (unsigned char*)d_ws;
#if N_LAUNCH_MODE == 1
    (void)hipMemsetAsync((char*)d_ws + WS_BAR, 0, WS_BAR_BYTES, stream);
    int lo = 0, hi = 18;
    void* args[] = {&p, &lo, &hi};
    hipError_t e = hipLaunchCooperativeKernel((const void*)hymba_mega, dim3(grid), dim3(512), args, LDS_BYTES, stream);
    if (e != hipSuccess) fprintf(stderr, "cooperative launch failed: %s (grid %d)\n", hipGetErrorString(e), grid);
#else
    for (int ph = 0; ph < 18; ++ph) hipLaunchKernelGGL(hymba_mega, dim3(grid), dim3(512), LDS_BYTES, stream, p, ph, ph + 1);
#endif
}
```
